# Optimizing an MI355X kernel written in HIP

```python
import math
import jax, jax.numpy as jnp
from jax import lax
import numpy as np

D_MODEL = 2048
BATCH = 8
SEQ = 4096
DEPTH = 2

N_MIXERS = 2
ATT_HEADS = 16
ATT_HEAD_DIM = D_MODEL // ATT_HEADS
DILATED_PATTERNS = ((128, 1), (512, 4), (2048, 16))
N_GROUPS = len(DILATED_PATTERNS)
REL_BUCKETS = 32
REL_MAX_DIST = 2048
RET_HEADS = D_MODEL // 256
RET_QK_DIM = D_MODEL
RET_V_DIM = 2 * D_MODEL
RET_HEAD_QK = RET_QK_DIM // RET_HEADS
RET_HEAD_V = RET_V_DIM // RET_HEADS
RET_CHUNK = 128
D_FF = ((8 * D_MODEL + 3 * 256 - 1) // (3 * 256)) * 256
NORM_EPS = 1e-6
MASK_VALUE = -1e30

kernel_name = "hybrid_dilated_attn_retention_block"


def rms_normalize(x):
    x32 = x.astype(jnp.float32)
    return x32 * lax.rsqrt(jnp.mean(x32 * x32, axis=-1, keepdims=True) + NORM_EPS)


def rms_norm(x, gain):
    return (rms_normalize(x) * gain.astype(jnp.float32)).astype(x.dtype)


def t5_bucket(dist):
    max_exact = REL_BUCKETS // 2
    d_f = jnp.maximum(dist, 1).astype(jnp.float32)
    large = max_exact + (jnp.log(d_f / max_exact) / math.log(REL_MAX_DIST / max_exact)
                         * (REL_BUCKETS - max_exact)).astype(jnp.int32)
    large = jnp.minimum(large, REL_BUCKETS - 1)
    return jnp.where(dist < max_exact, dist, large)


def dilated_group(q, k, v, window, dil, bias_table):
    B, S, H, Dh = q.shape
    steps = window // dil
    blk = steps
    span = dil * blk
    s_pad = -(-S // span) * span
    L = s_pad // dil
    nb = L // blk

    def to_blocks(t):
        t = jnp.pad(t, ((0, 0), (0, s_pad - S), (0, 0), (0, 0)))
        t = t.reshape(B, L, dil, H, Dh).transpose(0, 2, 1, 3, 4)
        return t.reshape(B, dil, nb, blk, H, Dh)

    def with_prev(t):
        prev = jnp.pad(t[:, :, :-1], ((0, 0), (0, 0), (1, 0), (0, 0), (0, 0), (0, 0)))
        return jnp.concatenate([prev, t], axis=3)

    qb = to_blocks(q)
    kk = with_prev(to_blocks(k))
    vv = with_prev(to_blocks(v))

    s = jnp.einsum("brnqhd,brnkhd->brnhqk", qb, kk).astype(jnp.float32) * (Dh ** -0.5)
    qi = jnp.arange(blk)[:, None]
    ki = jnp.arange(2 * blk)[None, :]
    delta = blk + qi - ki
    bucket = t5_bucket(jnp.maximum(delta, 0) * dil)
    bias = bias_table[bucket].transpose(2, 0, 1).astype(jnp.float32)
    valid = (delta >= 0) & (delta <= steps)
    first = (jnp.arange(nb) == 0)[:, None, None]
    valid = valid[None] & ~(first & (ki < blk)[None])
    s = jnp.where(valid[:, None], s + bias, MASK_VALUE)
    lse = jax.nn.logsumexp(s, axis=-1)
    p = jnp.exp(s - lse[..., None]).astype(v.dtype)
    o = jnp.einsum("brnhqk,brnkhd->brnqhd", p, vv)

    o = o.reshape(B, dil, L, H, Dh).transpose(0, 2, 1, 3, 4).reshape(B, s_pad, H, Dh)[:, :S]
    lse = lse.transpose(0, 1, 2, 4, 3).reshape(B, dil, L, H).transpose(0, 2, 1, 3)
    lse = lse.reshape(B, s_pad, H)[:, :S]
    return o, lse


def dilated_attention(h, w_qkv, q_gain, k_gain, w_o, rel_bias):
    B, S, _ = h.shape
    qkv = (h @ w_qkv).reshape(B, S, N_GROUPS, 3, ATT_HEADS, ATT_HEAD_DIM)
    outs, lses = [], []
    for g, (window, dil) in enumerate(DILATED_PATTERNS):
        q = rms_norm(qkv[:, :, g, 0], q_gain[g])
        k = rms_norm(qkv[:, :, g, 1], k_gain[g])
        v = qkv[:, :, g, 2]
        o, lse = dilated_group(q, k, v, window, dil,
                               rel_bias[:, g * ATT_HEADS:(g + 1) * ATT_HEADS])
        outs.append(o)
        lses.append(lse)
    weights = jax.nn.softmax(jnp.stack(lses, axis=-1), axis=-1)
    o = jnp.einsum("gbshd,bshg->bshd", jnp.stack(outs, axis=0), weights.astype(h.dtype))
    return o.reshape(B, S, D_MODEL) @ w_o


def retention_rotary(t):
    S = t.shape[1]
    half = t.shape[-1] // 2
    inv = 1.0 / (10000.0 ** jnp.linspace(0.0, 1.0, half, dtype=jnp.float32))
    ang = jnp.arange(S, dtype=jnp.float32)[:, None] * inv[None, :]
    cos = jnp.cos(ang)[None, :, None, :]
    sin = jnp.sin(ang)[None, :, None, :]
    t32 = t.astype(jnp.float32)
    t1, t2 = t32[..., :half], t32[..., half:]
    return jnp.concatenate([t1 * cos - t2 * sin, t1 * sin + t2 * cos], axis=-1)


def retention(h, w_qkvg, w_o):
    B, S, _ = h.shape
    q, k, v, g = jnp.split(h @ w_qkvg,
                           [RET_QK_DIM, 2 * RET_QK_DIM, 2 * RET_QK_DIM + RET_V_DIM], axis=-1)
    q = retention_rotary(q.reshape(B, S, RET_HEADS, RET_HEAD_QK))
    k = retention_rotary(k.reshape(B, S, RET_HEADS, RET_HEAD_QK)) * (RET_HEAD_QK ** -0.5)
    v = v.reshape(B, S, RET_HEADS, RET_HEAD_V).astype(jnp.float32)

    C = RET_CHUNK
    nc = S // C
    log_gamma = jnp.log(1.0 - 2.0 ** (-5.0 - jnp.arange(RET_HEADS, dtype=jnp.float32)))
    pos = jnp.arange(C, dtype=jnp.float32)
    diff = pos[:, None] - pos[None, :]
    inner_decay = jnp.where(diff[None] >= 0,
                            jnp.exp(jnp.maximum(diff, 0.0)[None] * log_gamma[:, None, None]),
                            0.0)
    cross_decay = jnp.exp((pos[:, None] + 1.0) * log_gamma[None, :])
    state_decay = jnp.exp((C - 1.0 - pos)[:, None] * log_gamma[None, :])
    chunk_decay = jnp.exp(C * log_gamma)

    def chunks(t):
        return jnp.moveaxis(t.reshape(B, nc, C, RET_HEADS, t.shape[-1]), 1, 0)

    def step(state, qkv_c):
        qc, kc, vc = qkv_c
        scores = jnp.einsum("bnhk,bmhk->bhnm", qc, kc) * inner_decay
        o = (jnp.einsum("bhnm,bmhv->bnhv", scores, vc)
             + jnp.einsum("bnhk,bhkv->bnhv", qc, state) * cross_decay[None, :, :, None])
        state = (state * chunk_decay[None, :, None, None]
                 + jnp.einsum("bmhk,bmhv->bhkv", kc * state_decay[None, :, :, None], vc))
        return state, o

    state0 = jnp.zeros((B, RET_HEADS, RET_HEAD_QK, RET_HEAD_V), jnp.float32)
    _, o = lax.scan(step, state0, (chunks(q), chunks(k), chunks(v)))
    o = jnp.moveaxis(o, 0, 1).reshape(B, S, RET_HEADS, RET_HEAD_V)
    o = rms_normalize(o).reshape(B, S, RET_V_DIM).astype(h.dtype)
    return (jax.nn.silu(g) * o) @ w_o


def swiglu(h, w_up, w_down):
    gate, up = jnp.split(h @ w_up, 2, axis=-1)
    return (jax.nn.silu(gate) * up) @ w_down


def setup_inputs(seed: int = 0) -> dict:
    key = jax.random.key(seed)
    ks = jax.random.split(key, 16)
    n_att = (DEPTH + N_MIXERS - 1) // N_MIXERS
    n_ret = DEPTH // N_MIXERS

    def nrm(k, shape, scale):
        return jax.random.normal(k, shape, jnp.float32) * scale

    return {
        "x": nrm(ks[0], (BATCH, SEQ, D_MODEL), 1.0),
        "c": nrm(ks[1], (BATCH, D_MODEL), 1.0),
        "w_mod": nrm(ks[2], (DEPTH, D_MODEL, 6 * D_MODEL), 0.5 * D_MODEL ** -0.5),
        "b_mod": nrm(ks[3], (DEPTH, 6 * D_MODEL), 0.02),
        "norm_mix": 1.0 + nrm(ks[4], (DEPTH, D_MODEL), 0.02),
        "norm_ffn": 1.0 + nrm(ks[5], (DEPTH, D_MODEL), 0.02),
        "rel_bias": nrm(ks[6], (REL_BUCKETS, N_GROUPS * ATT_HEADS), 0.5),
        "att_w_qkv": nrm(ks[7], (n_att, D_MODEL, N_GROUPS * 3 * ATT_HEADS * ATT_HEAD_DIM),
                          D_MODEL ** -0.5),
        "att_q_gain": 1.0 + nrm(ks[8], (n_att, N_GROUPS, ATT_HEAD_DIM), 0.02),
        "att_k_gain": 1.0 + nrm(ks[9], (n_att, N_GROUPS, ATT_HEAD_DIM), 0.02),
        "att_w_o": nrm(ks[10], (n_att, ATT_HEADS * ATT_HEAD_DIM, D_MODEL), D_MODEL ** -0.5),
        "ret_w_qkvg": nrm(ks[11], (n_ret, D_MODEL, 2 * RET_QK_DIM + 2 * RET_V_DIM),
                           D_MODEL ** -0.5),
        "ret_w_o": nrm(ks[12], (n_ret, RET_V_DIM, D_MODEL), RET_V_DIM ** -0.5),
        "ffn_w_up": nrm(ks[13], (DEPTH, D_MODEL, 2 * D_FF), D_MODEL ** -0.5),
        "ffn_w_down": nrm(ks[14], (DEPTH, D_FF, D_MODEL), D_FF ** -0.5),
    }


def reference(x, c, w_mod, b_mod, norm_mix, norm_ffn, rel_bias, att_w_qkv, att_q_gain,
              att_k_gain, att_w_o, ret_w_qkvg, ret_w_o, ffn_w_up, ffn_w_down):
    cond = jax.nn.silu(c)
    for i in range(DEPTH):
        mod = (cond @ w_mod[i] + b_mod[i])[:, None, :]
        sh1, sc1, g1, sh2, sc2, g2 = jnp.split(mod, 6, axis=-1)
        j = i // N_MIXERS
        h = rms_norm(x, norm_mix[i]) * (1.0 + sc1) + sh1
        if i % N_MIXERS == 0:
            y = dilated_attention(h, att_w_qkv[j], att_q_gain[j], att_k_gain[j], att_w_o[j],
                                  rel_bias)
        else:
            y = retention(h, ret_w_qkvg[j], ret_w_o[j])
        x = x + g1 * y
        h = rms_norm(x, norm_ffn[i]) * (1.0 + sc2) + sh2
        x = x + g2 * swiglu(h, ffn_w_up[i], ffn_w_down[i])
    return x
```

```cpp
#include <hip/hip_runtime.h>
#include <hip/hip_cooperative_groups.h>
#include <cstdio>
namespace cg = cooperative_groups;

#define LAS __attribute__((address_space(3)))
#define PG8_LAS LAS
typedef unsigned short bf16_t;
typedef short bf16x8 __attribute__((ext_vector_type(8)));
typedef float f32x4 __attribute__((ext_vector_type(4)));
typedef unsigned u32x4 __attribute__((ext_vector_type(4)));
typedef unsigned u32x2 __attribute__((ext_vector_type(2)));
#define DI __device__ __forceinline__

constexpr int TTOK = 32768, DM = 2048, SEQL = 4096, DFF = 5632, MODW = 12288;
constexpr float LOG2E = 1.4426950408889634f;
constexpr float NEPS = 1e-6f;
constexpr int LDS_BYTES = 147456;
constexpr int NTHREADS = 512;

constexpr size_t MB = 1048576;
constexpr size_t OFF_MOD = 0;
constexpr size_t OFF_COS = 1 * MB;
constexpr size_t OFF_SIN = 3 * MB;
constexpr size_t OFF_LSE = 5 * MB;
constexpr size_t OFF_SSQ = 8 * MB;
constexpr size_t OFF_H   = 16 * MB;
constexpr size_t OFF_W   = 144 * MB;
constexpr size_t OFF_WQKV0 = OFF_W;
constexpr size_t OFF_WO0   = OFF_WQKV0 + 72 * MB;
constexpr size_t OFF_WUP0  = OFF_WO0 + 8 * MB;
constexpr size_t OFF_WDN0  = OFF_WUP0 + 44 * MB;
constexpr size_t OFF_BIG0  = OFF_WDN0 + 22 * MB;
constexpr size_t OFF_QKVC  = OFF_BIG0;
constexpr size_t OFF_OG    = OFF_QKVC + 288 * MB;
constexpr size_t OFF_O     = OFF_OG + 96 * MB;
constexpr size_t OFF_HID0  = OFF_BIG0;
constexpr size_t OFF_WRQKV = OFF_W;
constexpr size_t OFF_WRG   = OFF_WRQKV + 32 * MB;
constexpr size_t OFF_WRO   = OFF_WRG + 16 * MB;
constexpr size_t OFF_BIG1  = OFF_WRO + 16 * MB;
constexpr size_t OFF_RQ    = OFF_BIG1;
constexpr size_t OFF_RK    = OFF_RQ + 128 * MB;
constexpr size_t OFF_RV    = OFF_RK + 128 * MB;
constexpr size_t OFF_RO    = OFF_RV + 256 * MB;
constexpr size_t OFF_WUP1  = OFF_BIG1;
constexpr size_t OFF_WDN1  = OFF_WUP1 + 44 * MB;
constexpr size_t OFF_HID1  = OFF_WDN1 + 22 * MB;
constexpr size_t WS_NEED   = OFF_RO + 256 * MB;

struct Params {
    const float *x, *c, *w_mod, *b_mod, *norm_mix, *norm_ffn, *rel_bias, *att_w_qkv, *att_q_gain, *att_k_gain, *att_w_o, *ret_w_qkvg, *ret_w_o, *ffn_w_up, *ffn_w_down;
    float* out; unsigned char* ws;
};

DI unsigned cvt_pk_bf16(float lo, float hi) { unsigned r; asm volatile("v_cvt_pk_bf16_f32 %0, %1, %2" : "=v"(r) : "v"(lo), "v"(hi)); return r; }
DI float bf_lo(unsigned u) { return __uint_as_float(u << 16); }
DI float bf_hi(unsigned u) { return __uint_as_float(u & 0xffff0000u); }
DI float silu_f(float v) { return v * __builtin_amdgcn_rcpf(1.0f + __expf(-v)); }
DI float shx(float v, int m) { return __shfl_xor(v, m); }

namespace pg8 {
constexpr int BM = 256, BK = 64, HALF = 128, HTB = HALF * BK * 2, STAGE_BYTES = 8 * HTB, NXCD = 8, WGM = 8;
__host__ __device__ __forceinline__ int lds_byte(int r, int c) { const int st = (r >> 4) * 2 + (c >> 5), rr = r & 15, cc = c & 31, ob = rr * 64 + cc * 2; return st * 1024 + (ob ^ (((ob >> 9) & 1) << 5)); }
__host__ __device__ __forceinline__ void stage_rc(int b, int& R, int& C) { const int st = b / 1024, sb = b % 1024, swz = sb ^ (((sb >> 9) & 1) << 5); R = (st >> 1) * 16 + swz / 64; C = (st & 1) * 32 + (swz % 64) / 2; }
__host__ __device__ __forceinline__ int perm32(int rho) { const int n = rho >> 4, i = rho & 15; return 8 * (i >> 2) + 4 * n + (i & 3); }
struct Unit { int pm, pn; };
struct Gemm { const bf16_t* A; const bf16_t* Bt; int M, N, K; };
struct StaticOrder {
    int nM, nN, nwg, G, c;
    __device__ void init(int M, int N, int G_, int c_) { nM = M / BM; nN = N / BM; nwg = nM * nN; G = G_; c = c_; }
    __device__ bool next(int i, Unit& u) const {
        const long L = (long)i * G + c; if (L >= nwg) return false;
        int wgid = (int)L; { const int q = nwg / NXCD, r = nwg % NXCD, xcd = wgid % NXCD, off = wgid / NXCD; wgid = (xcd < r ? xcd * (q + 1) : r * (q + 1) + (xcd - r) * q) + off; }
        const int nig = WGM * nN, gid = wgid / nig, fm = gid * WGM, gsz = (nM - fm) < WGM ? (nM - fm) : WGM;
        u.pm = fm + ((wgid % nig) % gsz); u.pn = (wgid % nig) / gsz; return true;
    }
    __device__ __forceinline__ void a_ready(const Unit&) const {}
    __device__ __forceinline__ void done(const Unit&) const {}
};
template <class Epi, class Sched>
__device__ __forceinline__ void gemm_phase(PG8_LAS unsigned char* lds, const Gemm g, const Sched& S, const Epi& E) {
    const int tid = threadIdx.x, wid = __builtin_amdgcn_readfirstlane(tid >> 6), lane = tid & 63, wr = wid >> 2, wc = wid & 3, fr = lane & 15, fq = lane >> 4;
    const int K = g.K, nt = K / BK;
    unsigned voffA[2], voffB[2];
#pragma unroll
    for (int i = 0; i < 2; ++i) { int R, C; stage_rc(tid * 16 + i * 8192, R, C); const int Rb = Epi::PERM ? ((R & ~31) + perm32(R & 31)) : R;
        voffA[i] = (unsigned)(R * K + C) * 2u; voffB[i] = (unsigned)(Rb * K + C) * 2u; }
    const size_t kstep = (size_t)(BK * 2);
    const size_t hstep = (size_t)HALF * K * 2;
    const size_t tstep = 2 * hstep;
    const unsigned ldsw = (unsigned)wid * 1024u;
    const int aoff = lds_byte(wr * 64 + fr, fq * 8), boff = lds_byte(wc * 32 + fr, fq * 8);
#define PG8_SA(b, h) (((b) * 2 + (h)) * HTB)
#define PG8_SB(b, h) ((4 + (b) * 2 + (h)) * HTB)
#define PG8_STAGE(bufoff, gbase, voff) do { _Pragma("unroll") for (int _i = 0; _i < 2; ++_i) \
        __builtin_amdgcn_global_load_lds((const unsigned*)((const char*)(gbase) + (voff)[_i]), (PG8_LAS unsigned*)(lds + (bufoff) + ldsw + _i * 8192), 16, 0, 0); } while (0)
#define PG8_LDA(dst, b, h) do { _Pragma("unroll") for (int m = 0; m < 4; ++m) _Pragma("unroll") for (int k = 0; k < 2; ++k) dst[m][k] = *(const PG8_LAS bf16x8*)(lds + PG8_SA(b, h) + aoff + m * 2048 + k * 1024); } while (0)
#define PG8_LDB(dst, b, h) do { _Pragma("unroll") for (int n = 0; n < 2; ++n) _Pragma("unroll") for (int k = 0; k < 2; ++k) dst[n][k] = *(const PG8_LAS bf16x8*)(lds + PG8_SB(b, h) + boff + n * 2048 + k * 1024); } while (0)
#define PG8_MMA(ai, bj, At, Bt) do { __builtin_amdgcn_s_setprio(1); _Pragma("unroll") for (int m = 0; m < 4; ++m) _Pragma("unroll") for (int n = 0; n < 2; ++n) _Pragma("unroll") for (int k = 0; k < 2; ++k) \
        acc[ai][bj][m][n] = __builtin_amdgcn_mfma_f32_16x16x32_bf16(Bt[n][k], At[m][k], acc[ai][bj][m][n], 0, 0, 0); __builtin_amdgcn_s_setprio(0); } while (0)
#define PG8_WAIT_V(n) asm volatile("s_waitcnt vmcnt(" #n ")" ::: "memory")
#define PG8_WAIT_L(n) asm volatile("s_waitcnt lgkmcnt(" #n ")" ::: "memory")
#define PG8_BAR __builtin_amdgcn_s_barrier()
#define PG8_SCHED __builtin_amdgcn_sched_barrier(0)
    Unit cur, nxt; int ui = 0;
    if (!S.next(0, cur)) return;
    f32x4 acc[2][2][4][2];
#pragma unroll
    for (int a = 0; a < 2; ++a)
#pragma unroll
        for (int b = 0; b < 2; ++b)
#pragma unroll
            for (int m = 0; m < 4; ++m)
#pragma unroll
                for (int n = 0; n < 2; ++n) acc[a][b][m][n] = (f32x4){0.f, 0.f, 0.f, 0.f};
    bf16x8 At[4][2], B0[2][2], B1[2][2];
    const char* cA = (const char*)g.A + (size_t)cur.pm * tstep; const char* cB = (const char*)g.Bt + (size_t)cur.pn * tstep;
    S.a_ready(cur);
    PG8_STAGE(PG8_SB(0, 0), cB, voffB); PG8_STAGE(PG8_SA(0, 0), cA, voffA); PG8_STAGE(PG8_SB(0, 1), cB + hstep, voffB); PG8_STAGE(PG8_SA(0, 1), cA + hstep, voffA);
    if (wr == 1) PG8_BAR;
    PG8_WAIT_V(4); PG8_BAR;
    PG8_STAGE(PG8_SB(1, 0), cB + kstep, voffB); PG8_STAGE(PG8_SA(1, 0), cA + kstep, voffA); PG8_STAGE(PG8_SB(1, 1), cB + hstep + kstep, voffB);
    PG8_WAIT_V(6); PG8_BAR;
    for (;;) {
        const bool has_next = S.next(ui + 1, nxt);
        const char* nA = has_next ? (const char*)g.A + (size_t)nxt.pm * tstep : cA; const char* nB = has_next ? (const char*)g.Bt + (size_t)nxt.pn * tstep : cB;
        for (int t = 0; t < nt; t += 2) {
            const bool last = (t == nt - 2);
            const char* a1 = cA + (size_t)(t + 1) * kstep;
            const char* a2 = last ? nA : cA + (size_t)(t + 2) * kstep; const char* b2 = last ? nB : cB + (size_t)(t + 2) * kstep;
            const char* a3 = a2 + kstep; const char* b3 = b2 + kstep;
            if (last && has_next) S.a_ready(nxt);
            PG8_LDB(B0, 0, 0); PG8_SCHED; PG8_LDA(At, 0, 0); PG8_STAGE(PG8_SA(1, 1), a1 + hstep, voffA);
            PG8_WAIT_L(8); PG8_BAR; PG8_WAIT_L(0); PG8_MMA(0, 0, At, B0); PG8_BAR; PG8_SCHED;
            PG8_LDB(B1, 0, 1); PG8_STAGE(PG8_SB(0, 0), b2, voffB);
            PG8_BAR; PG8_WAIT_L(0); PG8_MMA(0, 1, At, B1); PG8_BAR;
            PG8_LDA(At, 0, 1); PG8_STAGE(PG8_SA(0, 0), a2, voffA);
            PG8_BAR; PG8_WAIT_L(0); PG8_MMA(1, 0, At, B0); PG8_BAR; PG8_SCHED;
            PG8_STAGE(PG8_SB(0, 1), b2 + hstep, voffB);
            PG8_WAIT_V(6); PG8_BAR; PG8_MMA(1, 1, At, B1); PG8_BAR;
            PG8_LDB(B0, 1, 0); PG8_SCHED; PG8_LDA(At, 1, 0); PG8_STAGE(PG8_SA(0, 1), a2 + hstep, voffA);
            PG8_WAIT_L(8); PG8_BAR; PG8_WAIT_L(0); PG8_MMA(0, 0, At, B0); PG8_BAR; PG8_SCHED;
            PG8_LDB(B1, 1, 1); PG8_STAGE(PG8_SB(1, 0), b3, voffB);
            PG8_BAR; PG8_WAIT_L(0); PG8_MMA(0, 1, At, B1); PG8_BAR;
            PG8_LDA(At, 1, 1); PG8_STAGE(PG8_SA(1, 0), a3, voffA);
            PG8_BAR; PG8_WAIT_L(0); PG8_MMA(1, 0, At, B0); PG8_BAR; PG8_SCHED;
            PG8_STAGE(PG8_SB(1, 1), b3 + hstep, voffB);
            PG8_WAIT_V(6); PG8_BAR; PG8_MMA(1, 1, At, B1); PG8_BAR;
        }
        E(acc, cur, wr, wc, fr, fq); S.done(cur);
        if (!has_next) break;
#pragma unroll
        for (int a = 0; a < 2; ++a)
#pragma unroll
            for (int b = 0; b < 2; ++b)
#pragma unroll
                for (int m = 0; m < 4; ++m)
#pragma unroll
                    for (int n = 0; n < 2; ++n) acc[a][b][m][n] = (f32x4){0.f, 0.f, 0.f, 0.f};
        cur = nxt; cA = nA; cB = nB; ++ui;
    }
    PG8_WAIT_V(0);
    if (wr == 0) PG8_BAR;
    PG8_BAR;
#undef PG8_SA
#undef PG8_SB
#undef PG8_STAGE
#undef PG8_LDA
#undef PG8_LDB
#undef PG8_MMA
#undef PG8_WAIT_V
#undef PG8_WAIT_L
#undef PG8_BAR
#undef PG8_SCHED
}
}
using pg8::Unit;
typedef f32x4 AccT[2][2][4][2];

struct EpiPlainBf16 {
    static constexpr bool PERM = true;
    bf16_t* O; int ldc;
    DI void operator()(const AccT& acc, const Unit& u, int wr, int wc, int fr, int fq) const {
        const int row0 = u.pm * 256 + wr * 64 + fr, col0 = u.pn * 256 + wc * 32 + 8 * fq;
#pragma unroll
        for (int ai = 0; ai < 2; ++ai)
#pragma unroll
            for (int m = 0; m < 4; ++m) { bf16_t* rowp = O + (size_t)(row0 + ai * 128 + m * 16) * ldc + col0;
#pragma unroll
                for (int bj = 0; bj < 2; ++bj) { const f32x4 v0 = acc[ai][bj][m][0], v1 = acc[ai][bj][m][1];
                    u32x4 w; w.x = cvt_pk_bf16(v0[0], v0[1]); w.y = cvt_pk_bf16(v0[2], v0[3]); w.z = cvt_pk_bf16(v1[0], v1[1]); w.w = cvt_pk_bf16(v1[2], v1[3]);
                    *(u32x4*)(rowp + bj * 128) = w; } }
    }
};
struct EpiResid {
    static constexpr bool PERM = false;
    const float* R; float* O; const float* gate;
    DI void operator()(const AccT& acc, const Unit& u, int wr, int wc, int fr, int fq) const {
        const int row0 = u.pm * 256 + wr * 64 + fr, col0 = u.pn * 256 + wc * 32 + 4 * fq;
        const int b = (u.pm * 256) >> 12;
        f32x4 gv[2][2];
#pragma unroll
        for (int bj = 0; bj < 2; ++bj)
#pragma unroll
            for (int n = 0; n < 2; ++n) gv[bj][n] = *(const f32x4*)(gate + (size_t)b * MODW + col0 + bj * 128 + n * 16);
#pragma unroll
        for (int ai = 0; ai < 2; ++ai)
#pragma unroll
            for (int m = 0; m < 4; ++m) { const size_t ro = (size_t)(row0 + ai * 128 + m * 16) * DM + col0;
#pragma unroll
                for (int bj = 0; bj < 2; ++bj)
#pragma unroll
                    for (int n = 0; n < 2; ++n) { const f32x4 rv = *(const f32x4*)(R + ro + bj * 128 + n * 16);
                        *(f32x4*)(O + ro + bj * 128 + n * 16) = rv + gv[bj][n] * acc[ai][bj][m][n]; } }
    }
};
struct EpiSwiGLU {
    static constexpr bool PERM = true;
    bf16_t* O;
    DI void operator()(const AccT& acc, const Unit& u, int wr, int wc, int fr, int fq) const {
        const int row0 = u.pm * 256 + wr * 64 + fr, col0 = u.pn * 128 + wc * 32 + 8 * fq;
#pragma unroll
        for (int ai = 0; ai < 2; ++ai)
#pragma unroll
            for (int m = 0; m < 4; ++m) { bf16_t* rowp = O + (size_t)(row0 + ai * 128 + m * 16) * DFF + col0;
                float r[8];
#pragma unroll
                for (int n = 0; n < 2; ++n)
#pragma unroll
                    for (int e = 0; e < 4; ++e) r[n * 4 + e] = silu_f(acc[ai][0][m][n][e]) * acc[ai][1][m][n][e];
                u32x4 w; w.x = cvt_pk_bf16(r[0], r[1]); w.y = cvt_pk_bf16(r[2], r[3]); w.z = cvt_pk_bf16(r[4], r[5]); w.w = cvt_pk_bf16(r[6], r[7]);
                *(u32x4*)rowp = w; }
    }
};
struct EpiRetQKV {
    static constexpr bool PERM = true;
    bf16_t *Q, *Kt, *V; const float *cosT, *sinT;
    DI void operator()(const AccT& acc, const Unit& u, int wr, int wc, int fr, int fq) const {
        const int row0 = u.pm * 256 + wr * 64 + fr, i0 = wc * 32 + 8 * fq;
        if (u.pn >= 16) {
#pragma unroll
            for (int ai = 0; ai < 2; ++ai)
#pragma unroll
                for (int m = 0; m < 4; ++m) { bf16_t* rowp = V + (size_t)(row0 + ai * 128 + m * 16) * 4096 + (u.pn - 16) * 256 + i0;
#pragma unroll
                    for (int bj = 0; bj < 2; ++bj) { const f32x4 v0 = acc[ai][bj][m][0], v1 = acc[ai][bj][m][1];
                        u32x4 w; w.x = cvt_pk_bf16(v0[0], v0[1]); w.y = cvt_pk_bf16(v0[2], v0[3]); w.z = cvt_pk_bf16(v1[0], v1[1]); w.w = cvt_pk_bf16(v1[2], v1[3]);
                        *(u32x4*)(rowp + bj * 128) = w; } }
            return;
        }
        const bool isk = u.pn >= 8; const int hd = u.pn & 7;
        bf16_t* dst = (isk ? Kt : Q) + hd * 256 + i0;
        const float l2g = __log2f(1.0f - exp2f(-5.0f - (float)hd));
#pragma unroll
        for (int ai = 0; ai < 2; ++ai)
#pragma unroll
            for (int m = 0; m < 4; ++m) { const int row = row0 + ai * 128 + m * 16; const int s = row & 4095;
                const float sc = isk ? 0.0625f * exp2f(-(float)((s & 127) + 1) * l2g) : 1.0f;
                float o1[8], o2[8];
#pragma unroll
                for (int n = 0; n < 2; ++n) { const f32x4 cv = *(const f32x4*)(cosT + s * 128 + i0 + n * 4), sv = *(const f32x4*)(sinT + s * 128 + i0 + n * 4);
                    const f32x4 t1 = acc[ai][0][m][n], t2 = acc[ai][1][m][n];
#pragma unroll
                    for (int e = 0; e < 4; ++e) { o1[n * 4 + e] = (t1[e] * cv[e] - t2[e] * sv[e]) * sc; o2[n * 4 + e] = (t1[e] * sv[e] + t2[e] * cv[e]) * sc; } }
                u32x4 w1, w2;
                w1.x = cvt_pk_bf16(o1[0], o1[1]); w1.y = cvt_pk_bf16(o1[2], o1[3]); w1.z = cvt_pk_bf16(o1[4], o1[5]); w1.w = cvt_pk_bf16(o1[6], o1[7]);
                w2.x = cvt_pk_bf16(o2[0], o2[1]); w2.y = cvt_pk_bf16(o2[2], o2[3]); w2.z = cvt_pk_bf16(o2[4], o2[5]); w2.w = cvt_pk_bf16(o2[6], o2[7]);
                bf16_t* rp = dst + (size_t)row * 2048;
                *(u32x4*)rp = w1; *(u32x4*)(rp + 128) = w2; }
    }
};
struct EpiRetGate {
    static constexpr bool PERM = true;
    bf16_t* RO; const float* ssq;
    DI void operator()(const AccT& acc, const Unit& u, int wr, int wc, int fr, int fq) const {
        const int row0 = u.pm * 256 + wr * 64 + fr, col0 = u.pn * 256 + wc * 32 + 8 * fq, hd = u.pn >> 1;
#pragma unroll
        for (int ai = 0; ai < 2; ++ai)
#pragma unroll
            for (int m = 0; m < 4; ++m) { const int row = row0 + ai * 128 + m * 16;
                const f32x4 sq = *(const f32x4*)(ssq + (size_t)row * 32 + hd * 4);
                const float rn = rsqrtf((sq[0] + sq[1] + sq[2] + sq[3]) * (1.0f / 512.0f) + NEPS);
                bf16_t* rowp = RO + (size_t)row * 4096 + col0;
#pragma unroll
                for (int bj = 0; bj < 2; ++bj) { const u32x4 ov = *(const u32x4*)(rowp + bj * 128);
                    const f32x4 g0 = acc[ai][bj][m][0], g1 = acc[ai][bj][m][1];
                    u32x4 w;
                    w.x = cvt_pk_bf16(silu_f(g0[0]) * bf_lo(ov.x) * rn, silu_f(g0[1]) * bf_hi(ov.x) * rn);
                    w.y = cvt_pk_bf16(silu_f(g0[2]) * bf_lo(ov.y) * rn, silu_f(g0[3]) * bf_hi(ov.y) * rn);
                    w.z = cvt_pk_bf16(silu_f(g1[0]) * bf_lo(ov.z) * rn, silu_f(g1[1]) * bf_hi(ov.z) * rn);
                    w.w = cvt_pk_bf16(silu_f(g1[2]) * bf_lo(ov.w) * rn, silu_f(g1[3]) * bf_hi(ov.w) * rn);
                    *(u32x4*)(rowp + bj * 128) = w; } }
    }
};

struct CJob { const float* src; bf16_t* dst; int ldsrc, K, nrows, mode, coff; };
DI void convert_w(const CJob j, LAS unsigned* lw) {
    const int tid = threadIdx.x, ntR = j.nrows >> 6, ntK = j.K >> 7, total = ntR * ntK;
    const int nq = tid & 15, kr = tid >> 4;
    for (int tile = blockIdx.x; tile < total; tile += gridDim.x) {
        const int rt = tile % ntR, kt = tile / ntR, R0 = rt * 64, k0 = kt * 128;
        const int c0 = j.mode == 0 ? j.coff + R0 : ((R0 >> 7) & 1) * DFF + (R0 >> 8) * 128 + (R0 & 127);
        f32x4 a[2][2];
#pragma unroll
        for (int p = 0; p < 2; ++p) { const int kp = p * 32 + kr; const float* s = j.src + (size_t)(k0 + 2 * kp) * j.ldsrc + c0 + 4 * nq;
            a[p][0] = *(const f32x4*)s; a[p][1] = *(const f32x4*)(s + j.ldsrc); }
#pragma unroll
        for (int p = 0; p < 2; ++p) { const int kp = p * 32 + kr;
#pragma unroll
            for (int e = 0; e < 4; ++e) lw[(4 * nq + e) * 65 + kp] = cvt_pk_bf16(a[p][0][e], a[p][1][e]); }
        __syncthreads();
#pragma unroll
        for (int i = 0; i < 2; ++i) { const int idx = tid + 512 * i, n = idx >> 4, ch = idx & 15;
            u32x4 v; v.x = lw[n * 65 + 4 * ch]; v.y = lw[n * 65 + 4 * ch + 1]; v.z = lw[n * 65 + 4 * ch + 2]; v.w = lw[n * 65 + 4 * ch + 3];
            *(u32x4*)(j.dst + (size_t)(R0 + n) * j.K + k0 + 8 * ch) = v; }
        __syncthreads();
    }
}
DI void convert_set(const Params& P, int set, LAS unsigned* lw) {
    const int njobs = set == 0 ? 4 : (set == 1 ? 3 : 2);
    for (int ji = 0; ji < njobs; ++ji) {
        CJob j;
        const int id = set * 4 + ji;
        switch (id) {
            case 0:  j = CJob{P.att_w_qkv, (bf16_t*)(P.ws + OFF_WQKV0), 18432, 2048, 18432, 0, 0}; break;
            case 1:  j = CJob{P.att_w_o, (bf16_t*)(P.ws + OFF_WO0), 2048, 2048, 2048, 0, 0}; break;
            case 2:  j = CJob{P.ffn_w_up, (bf16_t*)(P.ws + OFF_WUP0), 11264, 2048, 11264, 1, 0}; break;
            case 3:  j = CJob{P.ffn_w_down, (bf16_t*)(P.ws + OFF_WDN0), 2048, 5632, 2048, 0, 0}; break;
            case 4:  j = CJob{P.ret_w_qkvg, (bf16_t*)(P.ws + OFF_WRQKV), 12288, 2048, 8192, 0, 0}; break;
            case 5:  j = CJob{P.ret_w_qkvg, (bf16_t*)(P.ws + OFF_WRG), 12288, 2048, 4096, 0, 8192}; break;
            case 6:  j = CJob{P.ret_w_o, (bf16_t*)(P.ws + OFF_WRO), 2048, 4096, 2048, 0, 0}; break;
            case 8:  j = CJob{P.ffn_w_up + (size_t)2048 * 11264, (bf16_t*)(P.ws + OFF_WUP1), 11264, 2048, 11264, 1, 0}; break;
            default: j = CJob{P.ffn_w_down + (size_t)5632 * 2048, (bf16_t*)(P.ws + OFF_WDN1), 2048, 5632, 2048, 0, 0}; break;
        }
        convert_w(j, lw);
    }
}

DI void mod_gemv(const Params& P, LAS float* lf) {
    const int tid = threadIdx.x;
    if (blockIdx.x >= 192) return;
    for (int i = tid; i < 8 * 2048; i += NTHREADS) lf[i] = silu_f(P.c[i]);
    __syncthreads();
    LAS float* red = lf + 16384;
    float* mod = (float*)(P.ws + OFF_MOD);
    for (int item = blockIdx.x; item < 192; item += gridDim.x) {
        const int l = item / 96, nb = item % 96, cl = tid & 127, kq = tid >> 7;
        const float* w = P.w_mod + ((size_t)l * 2048 + kq * 512) * MODW + nb * 128 + cl;
        float a0 = 0.f, a1 = 0.f, a2 = 0.f, a3 = 0.f, a4 = 0.f, a5 = 0.f, a6 = 0.f, a7 = 0.f;
        const LAS float* cs = lf + kq * 512;
#pragma unroll 8
        for (int k = 0; k < 512; ++k) { const float wv = w[(size_t)k * MODW];
            a0 += cs[k] * wv; a1 += cs[2048 + k] * wv; a2 += cs[4096 + k] * wv; a3 += cs[6144 + k] * wv;
            a4 += cs[8192 + k] * wv; a5 += cs[10240 + k] * wv; a6 += cs[12288 + k] * wv; a7 += cs[14336 + k] * wv; }
        LAS float* rp = red + (kq * 128 + cl) * 8;
        rp[0] = a0; rp[1] = a1; rp[2] = a2; rp[3] = a3; rp[4] = a4; rp[5] = a5; rp[6] = a6; rp[7] = a7;
        __syncthreads();
        for (int i = tid; i < 1024; i += NTHREADS) { const int cc = i >> 3, b = i & 7;
            const float s = red[(0 * 128 + cc) * 8 + b] + red[(1 * 128 + cc) * 8 + b] + red[(2 * 128 + cc) * 8 + b] + red[(3 * 128 + cc) * 8 + b];
            mod[(size_t)(l * 8 + b) * MODW + nb * 128 + cc] = s + P.b_mod[l * MODW + nb * 128 + cc]; }
        __syncthreads();
    }
}
DI void rotary_tables(const Params& P) {
    float* cosT = (float*)(P.ws + OFF_COS); float* sinT = (float*)(P.ws + OFF_SIN);
    for (int i = blockIdx.x * NTHREADS + threadIdx.x; i < 4096 * 128; i += gridDim.x * NTHREADS) {
        const int s = i >> 7, jx = i & 127;
        const float inv = 1.0f / exp2f((float)jx * (13.287712379549449f / 127.0f));
        const float ang = (float)s * inv;
        const float nn = rintf(ang * 0.15915494309189535f);
        float r = fmaf(-nn, 6.2831854820251465f, ang); r = fmaf(-nn, -1.7484555e-07f, r);
        cosT[i] = __cosf(r); sinT[i] = __sinf(r);
    }
}

DI void norm_phase(const Params& P, int l, int which) {
    const float* src = (l == 0 && which == 0) ? P.x : P.out;
    const float* gain = (which ? P.norm_ffn : P.norm_mix) + l * DM;
    const float* mod = (const float*)(P.ws + OFF_MOD) + (size_t)l * 8 * MODW;
    bf16_t* H = (bf16_t*)(P.ws + OFF_H);
    const int lane = threadIdx.x & 63, gw = blockIdx.x * 8 + (threadIdx.x >> 6), nw = gridDim.x * 8;
    for (int row = gw; row < TTOK; row += nw) {
        const int b = row >> 12;
        const float* sh = mod + (size_t)b * MODW + (which ? 3 : 0) * DM; const float* sc = mod + (size_t)b * MODW + (which ? 4 : 1) * DM;
        const float* xr = src + (size_t)row * DM;
        f32x4 v[8]; float ss = 0.f;
#pragma unroll
        for (int i = 0; i < 8; ++i) { v[i] = *(const f32x4*)(xr + 4 * lane + 256 * i); ss += v[i][0] * v[i][0] + v[i][1] * v[i][1] + v[i][2] * v[i][2] + v[i][3] * v[i][3]; }
        ss += shx(ss, 1); ss += shx(ss, 2); ss += shx(ss, 4); ss += shx(ss, 8); ss += shx(ss, 16); ss += shx(ss, 32);
        const float rs = rsqrtf(ss * (1.0f / 2048.0f) + NEPS);
        bf16_t* hr = H + (size_t)row * DM;
#pragma unroll
        for (int i = 0; i < 8; ++i) { const int cc = 4 * lane + 256 * i;
            const f32x4 gv = *(const f32x4*)(gain + cc), sv = *(const f32x4*)(sc + cc), hv = *(const f32x4*)(sh + cc);
            f32x4 o;
#pragma unroll
            for (int e = 0; e < 4; ++e) o[e] = v[i][e] * rs * gv[e] * (1.0f + sv[e]) + hv[e];
            u32x2 w; w.x = cvt_pk_bf16(o[0], o[1]); w.y = cvt_pk_bf16(o[2], o[3]);
            *(u32x2*)(hr + cc) = w; }
    }
}
DI int t5_bucket(int dist) {
    if (dist < 16) return dist;
    const float v = logf((float)dist / 16.0f) / 4.852030263919617f * 16.0f;
    const int lg = 16 + (int)v;
    return lg < 31 ? lg : 31;
}
#define MFMA16(a, b, c) __builtin_amdgcn_mfma_f32_16x16x32_bf16((a), (b), (c), 0, 0, 0)
DI bf16x8 gather_col(const LAS unsigned char* p0, const LAS unsigned char* p1, int stride) {
    bf16x8 r;
    r[0] = *(const LAS short*)(p0); r[1] = *(const LAS short*)(p0 + stride); r[2] = *(const LAS short*)(p0 + 2 * stride); r[3] = *(const LAS short*)(p0 + 3 * stride);
    r[4] = *(const LAS short*)(p1); r[5] = *(const LAS short*)(p1 + stride); r[6] = *(const LAS short*)(p1 + 2 * stride); r[7] = *(const LAS short*)(p1 + 3 * stride);
    return r;
}
DI bf16x8 pack8(const float* f) { u32x4 w; w.x = cvt_pk_bf16(f[0], f[1]); w.y = cvt_pk_bf16(f[2], f[3]); w.z = cvt_pk_bf16(f[4], f[5]); w.w = cvt_pk_bf16(f[6], f[7]); return __builtin_bit_cast(bf16x8, w); }

DI void attn_phase(const Params& P, LAS unsigned char* L) {
    const bf16_t* QKV = (const bf16_t*)(P.ws + OFF_QKVC);
    bf16_t* OG = (bf16_t*)(P.ws + OFF_OG); float* LSE = (float*)(P.ws + OFF_LSE);
    const int tid = threadIdx.x, lane = tid & 63, w = __builtin_amdgcn_readfirstlane(tid >> 6), fr = lane & 15, fq = lane >> 4;
    LAS unsigned char* Ks = L; LAS unsigned char* Vs = L + 65536; LAS float* biasL = (LAS float*)(L + 131072);
    for (int it = blockIdx.x; it < 3072; it += gridDim.x) {
        const int blk = it & 31, h = (it >> 5) & 15, gb = it >> 9, g = gb % 3, bb = gb / 3;
        const int l2d = 2 * g, dil = 1 << l2d, r = blk & (dil - 1), n = blk >> l2d;
        const size_t rowbase = (size_t)bb * 4096;
        const int colq = g * 6144 + h * 128;
        if (tid < 129) { const int bk = t5_bucket(tid * dil); biasL[tid] = P.rel_bias[bk * 48 + g * 16 + h] * LOG2E; }
        {
            const int ch = tid & 15;
            const f32x4 kg0 = *(const f32x4*)(P.att_k_gain + g * 128 + ch * 8), kg1 = *(const f32x4*)(P.att_k_gain + g * 128 + ch * 8 + 4);
#pragma unroll
            for (int i = 0; i < 8; ++i) {
                const int jj = (tid >> 4) + 32 * i, idx = n * 128 - 128 + jj;
                u32x4 kv = (u32x4){0u, 0u, 0u, 0u}, vv = (u32x4){0u, 0u, 0u, 0u};
                if (idx >= 0) { const bf16_t* p = QKV + (rowbase + (size_t)idx * dil + r) * 18432 + colq + ch * 8; kv = *(const u32x4*)(p + 2048); vv = *(const u32x4*)(p + 4096); }
                float f[8] = {bf_lo(kv.x), bf_hi(kv.x), bf_lo(kv.y), bf_hi(kv.y), bf_lo(kv.z), bf_hi(kv.z), bf_lo(kv.w), bf_hi(kv.w)};
                float ss = 0.f;
#pragma unroll
                for (int e = 0; e < 8; ++e) ss += f[e] * f[e];
                ss += shx(ss, 1); ss += shx(ss, 2); ss += shx(ss, 4); ss += shx(ss, 8);
                const float rk = rsqrtf(ss * (1.0f / 128.0f) + NEPS);
#pragma unroll
                for (int e = 0; e < 4; ++e) { f[e] *= rk * kg0[e]; f[4 + e] *= rk * kg1[e]; }
                *(LAS bf16x8*)(Ks + jj * 256 + ((ch ^ (jj & 15)) << 4)) = pack8(f);
                *(LAS u32x4*)(Vs + jj * 256 + ch * 16) = vv;
            }
        }
        const int jq = 16 * w + fr;
        const size_t qrow = rowbase + (size_t)(n * 128 + jq) * dil + r;
        bf16x8 qf[4];
        {
            const bf16_t* qp = QKV + qrow * 18432 + colq + 8 * fq;
            u32x4 raw[4]; float ss = 0.f;
#pragma unroll
            for (int ks = 0; ks < 4; ++ks) { raw[ks] = *(const u32x4*)(qp + 32 * ks);
                const float f[8] = {bf_lo(raw[ks].x), bf_hi(raw[ks].x), bf_lo(raw[ks].y), bf_hi(raw[ks].y), bf_lo(raw[ks].z), bf_hi(raw[ks].z), bf_lo(raw[ks].w), bf_hi(raw[ks].w)};
#pragma unroll
                for (int e = 0; e < 8; ++e) ss += f[e] * f[e]; }
            ss += shx(ss, 16); ss += shx(ss, 32);
            const float rq = rsqrtf(ss * (1.0f / 128.0f) + NEPS) * (0.08838834764831845f * LOG2E);
#pragma unroll
            for (int ks = 0; ks < 4; ++ks) { const float* gp = P.att_q_gain + g * 128 + 32 * ks + 8 * fq; const f32x4 g0 = *(const f32x4*)gp, g1 = *(const f32x4*)(gp + 4);
                float f[8] = {bf_lo(raw[ks].x), bf_hi(raw[ks].x), bf_lo(raw[ks].y), bf_hi(raw[ks].y), bf_lo(raw[ks].z), bf_hi(raw[ks].z), bf_lo(raw[ks].w), bf_hi(raw[ks].w)};
#pragma unroll
                for (int e = 0; e < 4; ++e) { f[e] *= rq * g0[e]; f[4 + e] *= rq * g1[e]; }
                qf[ks] = pack8(f); }
        }
        __syncthreads();
        f32x4 sc[9];
#pragma unroll
        for (int tt = 0; tt < 9; ++tt) { f32x4 a = (f32x4){0.f, 0.f, 0.f, 0.f}; const int row = 16 * (w + tt) + fr;
#pragma unroll
            for (int ks = 0; ks < 4; ++ks) { const bf16x8 kf = *(const LAS bf16x8*)(Ks + row * 256 + (((4 * ks + fq) ^ fr) << 4)); a = MFMA16(kf, qf[ks], a); }
            sc[tt] = a; }
        float mx = -3.0e38f;
#pragma unroll
        for (int tt = 0; tt < 9; ++tt)
#pragma unroll
            for (int j = 0; j < 4; ++j) { const int delta = 128 + fr - 16 * tt - 4 * fq - j; const int ki = 16 * (w + tt) + 4 * fq + j;
                const bool valid = (delta >= 0) && (delta <= 128) && (n > 0 || ki >= 128);
                const int dc = delta < 0 ? 0 : (delta > 128 ? 128 : delta);
                const float s = valid ? sc[tt][j] + biasL[dc] : -1.0e30f;
                sc[tt][j] = s; mx = fmaxf(mx, s); }
        mx = fmaxf(mx, shx(mx, 16)); mx = fmaxf(mx, shx(mx, 32));
        float sum = 0.f;
#pragma unroll
        for (int tt = 0; tt < 9; ++tt)
#pragma unroll
            for (int j = 0; j < 4; ++j) { const float p = __builtin_amdgcn_exp2f(sc[tt][j] - mx); sc[tt][j] = p; sum += p; }
        sum += shx(sum, 16); sum += shx(sum, 32);
        f32x4 oacc[8];
#pragma unroll
        for (int dt = 0; dt < 8; ++dt) oacc[dt] = (f32x4){0.f, 0.f, 0.f, 0.f};
#pragma unroll
        for (int s2 = 0; s2 < 5; ++s2) {
            const int t0 = w + 2 * s2; int t1 = w + 2 * s2 + 1; t1 = t1 > 15 ? 15 : t1;
            float pf[8];
#pragma unroll
            for (int j = 0; j < 4; ++j) { pf[j] = sc[2 * s2][j]; pf[4 + j] = (2 * s2 + 1 <= 8) ? sc[(2 * s2 + 1 <= 8) ? 2 * s2 + 1 : 8][j] : 0.f; }
            const bf16x8 pb = pack8(pf);
            const LAS unsigned char* v0 = Vs + (16 * t0 + 4 * fq) * 256 + fr * 2; const LAS unsigned char* v1 = Vs + (16 * t1 + 4 * fq) * 256 + fr * 2;
#pragma unroll
            for (int dt = 0; dt < 8; ++dt) { const bf16x8 vf = gather_col(v0 + dt * 32, v1 + dt * 32, 256); oacc[dt] = MFMA16(vf, pb, oacc[dt]); }
        }
        const float inv = 1.0f / sum;
        bf16_t* op = OG + ((size_t)g * 8192 + qrow) * 2048 + h * 128 + 4 * fq;
#pragma unroll
        for (int dt = 0; dt < 8; ++dt) { u32x2 wv; wv.x = cvt_pk_bf16(oacc[dt][0] * inv, oacc[dt][1] * inv); wv.y = cvt_pk_bf16(oacc[dt][2] * inv, oacc[dt][3] * inv); *(u32x2*)(op + 16 * dt) = wv; }
        if (fq == 0) LSE[((size_t)g * 8192 + qrow) * 16 + h] = mx + __log2f(sum);
        __syncthreads();
    }
}
DI void merge_phase(const Params& P, int cb) {
    const bf16_t* OG = (const bf16_t*)(P.ws + OFF_OG); const float* LSE = (const float*)(P.ws + OFF_LSE);
    bf16_t* O = (bf16_t*)(P.ws + OFF_O) + (size_t)cb * 8192 * 2048;
    const int tid = threadIdx.x;
    for (int pr = blockIdx.x; pr < 4096; pr += gridDim.x) {
        const int tok = pr * 2 + (tid >> 8), c8 = (tid & 255) * 8, h = c8 >> 7;
        const float l0 = LSE[((size_t)0 * 8192 + tok) * 16 + h], l1 = LSE[((size_t)1 * 8192 + tok) * 16 + h], l2 = LSE[((size_t)2 * 8192 + tok) * 16 + h];
        const float m = fmaxf(l0, fmaxf(l1, l2));
        float w0 = __builtin_amdgcn_exp2f(l0 - m), w1 = __builtin_amdgcn_exp2f(l1 - m), w2 = __builtin_amdgcn_exp2f(l2 - m);
        const float inv = 1.0f / (w0 + w1 + w2); w0 *= inv; w1 *= inv; w2 *= inv;
        const u32x4 a = *(const u32x4*)(OG + ((size_t)0 * 8192 + tok) * 2048 + c8), b = *(const u32x4*)(OG + ((size_t)1 * 8192 + tok) * 2048 + c8), c = *(const u32x4*)(OG + ((size_t)2 * 8192 + tok) * 2048 + c8);
        u32x4 o;
        o.x = cvt_pk_bf16(w0 * bf_lo(a.x) + w1 * bf_lo(b.x) + w2 * bf_lo(c.x), w0 * bf_hi(a.x) + w1 * bf_hi(b.x) + w2 * bf_hi(c.x));
        o.y = cvt_pk_bf16(w0 * bf_lo(a.y) + w1 * bf_lo(b.y) + w2 * bf_lo(c.y), w0 * bf_hi(a.y) + w1 * bf_hi(b.y) + w2 * bf_hi(c.y));
        o.z = cvt_pk_bf16(w0 * bf_lo(a.z) + w1 * bf_lo(b.z) + w2 * bf_lo(c.z), w0 * bf_hi(a.z) + w1 * bf_hi(b.z) + w2 * bf_hi(c.z));
        o.w = cvt_pk_bf16(w0 * bf_lo(a.w) + w1 * bf_lo(b.w) + w2 * bf_lo(c.w), w0 * bf_hi(a.w) + w1 * bf_hi(b.w) + w2 * bf_hi(c.w));
        *(u32x4*)(O + (size_t)tok * 2048 + c8) = o;
    }
}
DI int swz32(int chunk, int row) { return (((chunk & 15) ^ (row & 15)) | (chunk & 16)) << 4; }
DI void scan_phase(const Params& P, LAS unsigned char* L) {
    const bf16_t* RQ = (const bf16_t*)(P.ws + OFF_RQ); const bf16_t* RK = (const bf16_t*)(P.ws + OFF_RK); const bf16_t* RV = (const bf16_t*)(P.ws + OFF_RV);
    bf16_t* RO = (bf16_t*)(P.ws + OFF_RO); float* SSQ = (float*)(P.ws + OFF_SSQ);
    const int tid = threadIdx.x, lane = tid & 63, w = __builtin_amdgcn_readfirstlane(tid >> 6), fr = lane & 15, fq = lane >> 4;
    LAS unsigned char* R = L; LAS unsigned char* Vs = L + 65536;
    int xb[4], kb[2][4], wb[2];
#pragma unroll
    for (int a = 0; a < 4; ++a) xb[a] = fr * 512 + (((4 * a + fq) ^ fr) << 4);
#pragma unroll
    for (int a = 0; a < 2; ++a) {
#pragma unroll
        for (int j3 = 0; j3 < 4; ++j3) kb[a][j3] = (4 * fq + j3) * 512 + ((((4 * w + 2 * a + (fr >> 3)) & 15) ^ (4 * fq + j3)) << 4) + ((w >> 2) << 8) + (fr & 7) * 2;
        wb[a] = fr * 512 + ((((4 * w + 2 * a + (fq >> 1)) & 15) ^ fr) << 4) + ((w >> 2) << 8) + (fq & 1) * 8; }
    for (int it = blockIdx.x; it < 256; it += gridDim.x) {
        const int vs = it & 3, h = (it >> 2) & 7, b = it >> 5;
        const float l2g = __log2f(1.0f - exp2f(-5.0f - (float)h));
        const float gC = exp2f(128.0f * l2g);
        f32x4 sacc[2][8];
#pragma unroll
        for (int a = 0; a < 2; ++a)
#pragma unroll
            for (int v = 0; v < 8; ++v) sacc[a][v] = (f32x4){0.f, 0.f, 0.f, 0.f};
#pragma unroll
        for (int i = 0; i < 8; ++i) *(LAS u32x4*)(R + (tid + 512 * i) * 16) = (u32x4){0u, 0u, 0u, 0u};
        __syncthreads();
        for (int c = 0; c < 32; ++c) {
            const size_t t0 = (size_t)b * 4096 + c * 128;
            bf16x8 qf[8];
            { const bf16_t* qp = RQ + (t0 + 16 * w) * 2048 + h * 256; const unsigned qo = (unsigned)(fr * 2048 + 8 * fq);
#pragma unroll
              for (int ks = 0; ks < 8; ++ks) qf[ks] = *(const bf16x8*)(qp + (qo + 32 * ks)); }
#pragma unroll
            for (int i = 0; i < 4; ++i) { const int e = tid + 512 * i, m = e >> 4, ch = e & 15;
                const bf16_t* vp = RV + (t0 + 32 * i) * 4096 + h * 512 + vs * 128; const unsigned vo = (unsigned)((tid >> 4) * 4096 + ch * 8);
                *(LAS u32x4*)(Vs + m * 256 + ch * 16) = *(const u32x4*)(vp + vo); }
            f32x4 oacc[8];
#pragma unroll
            for (int vt = 0; vt < 8; ++vt) { f32x4 a = (f32x4){0.f, 0.f, 0.f, 0.f};
#pragma unroll
                for (int ks = 0; ks < 8; ++ks) { const bf16x8 sf = *(const LAS bf16x8*)(R + vt * 8192 + xb[ks & 3] + (ks >> 2) * 256); a = MFMA16(sf, qf[ks], a); }
                oacc[vt] = a; }
            __syncthreads();
            { u32x4 kreg[8];
#pragma unroll
              for (int i = 0; i < 8; ++i) { const bf16_t* kp = RK + (t0 + 16 * i) * 2048 + h * 256; const unsigned ko = (unsigned)((tid >> 5) * 2048 + (tid & 31) * 8); kreg[i] = *(const u32x4*)(kp + ko); }
#pragma unroll
              for (int i = 0; i < 8; ++i) { const int e = tid + 512 * i, m = e >> 5, ch = e & 31; *(LAS u32x4*)(R + m * 512 + swz32(ch, m)) = kreg[i]; } }
            __syncthreads();
            unsigned pk[8][2];
#pragma unroll
            for (int mt = 0; mt < 8; ++mt) {
                f32x4 a = (f32x4){0.f, 0.f, 0.f, 0.f};
                if (mt <= w) {
#pragma unroll
                    for (int ks = 0; ks < 8; ++ks) { const bf16x8 kf = *(const LAS bf16x8*)(R + mt * 8192 + xb[ks & 3] + (ks >> 2) * 256); a = MFMA16(kf, qf[ks], a); }
#pragma unroll
                    for (int j = 0; j < 4; ++j) a[j] = (mt < w || 4 * fq + j <= fr) ? a[j] : 0.f; }
                pk[mt][0] = cvt_pk_bf16(a[0], a[1]); pk[mt][1] = cvt_pk_bf16(a[2], a[3]); }
#pragma unroll
            for (int ms = 0; ms < 4; ++ms) {
                u32x4 pw; pw.x = pk[2 * ms][0]; pw.y = pk[2 * ms][1]; pw.z = pk[2 * ms + 1][0]; pw.w = pk[2 * ms + 1][1];
                const bf16x8 pb = __builtin_bit_cast(bf16x8, pw);
                bf16x8 kf0, kf1;
#pragma unroll
                for (int j = 0; j < 8; ++j) { const int mo = (32 * ms + 16 * (j >> 2)) * 512;
                    kf0[j] = *(const LAS short*)(R + kb[0][j & 3] + mo);
                    kf1[j] = *(const LAS short*)(R + kb[1][j & 3] + mo); }
                const LAS unsigned char* v0 = Vs + (32 * ms + 4 * fq) * 256 + fr * 2; const LAS unsigned char* v1 = v0 + 16 * 256;
#pragma unroll
                for (int vt = 0; vt < 8; ++vt) { const bf16x8 vf = gather_col(v0 + vt * 32, v1 + vt * 32, 256);
                    if (2 * ms <= w) oacc[vt] = MFMA16(vf, pb, oacc[vt]);
                    sacc[0][vt] = MFMA16(kf0, vf, sacc[0][vt]); sacc[1][vt] = MFMA16(kf1, vf, sacc[1][vt]); if (vt & 1) __builtin_amdgcn_sched_barrier(0); }
            }
            {
                const float dn = exp2f((float)(16 * w + fr + 1) * l2g);
                bf16_t* op = RO + (t0 + 16 * w) * 4096 + h * 512 + vs * 128 + (unsigned)(fr * 4096 + 4 * fq);
                float ss = 0.f;
#pragma unroll
                for (int vt = 0; vt < 8; ++vt) { const f32x4 o = oacc[vt] * dn; ss += o[0] * o[0] + o[1] * o[1] + o[2] * o[2] + o[3] * o[3];
                    u32x2 wv; wv.x = cvt_pk_bf16(o[0], o[1]); wv.y = cvt_pk_bf16(o[2], o[3]); *(u32x2*)(op + 16 * vt) = wv; }
                ss += shx(ss, 16); ss += shx(ss, 32);
                if (fq == 0) (SSQ + (t0 + 16 * w) * 32 + h * 4 + vs)[(unsigned)(fr * 32)] = ss;
            }
#pragma unroll
            for (int a = 0; a < 2; ++a)
#pragma unroll
                for (int v = 0; v < 8; ++v) sacc[a][v] *= gC;
            __syncthreads();
#pragma unroll
            for (int a = 0; a < 2; ++a)
#pragma unroll
                for (int vt = 0; vt < 8; ++vt) {
                    u32x2 wv; wv.x = cvt_pk_bf16(sacc[a][vt][0], sacc[a][vt][1]); wv.y = cvt_pk_bf16(sacc[a][vt][2], sacc[a][vt][3]);
                    *(LAS u32x2*)(R + vt * 8192 + wb[a]) = wv; }
            __syncthreads();
        }
    }
}

constexpr int NPH = 26;
constexpr int MAXPH = 26;
DI void decode_phase(int ph, int& type, int& a0, int& a1, int& a2) {
    a0 = 0; a1 = 0; a2 = -1;
    if (ph == 0) type = 0;
    else if (ph == 1) { type = 1; }
    else if (ph < 14) { const int q = (ph - 2) / 3, rr = (ph - 2) % 3; type = 2 + rr; a0 = q; }
    else if (ph == 14) { type = 5; a0 = 0; }
    else if (ph == 15) { type = 1; a0 = 0; a1 = 1; }
    else if (ph == 16) { type = 6; a0 = 0; }
    else if (ph == 17) { type = 5; a0 = 1; }
    else if (ph == 18) { type = 1; a0 = 1; a1 = 0; a2 = 1; }
    else if (ph == 19) type = 7;
    else if (ph == 20) type = 8;
    else if (ph == 21) type = 9;
    else if (ph == 22) { type = 5; a0 = 2; }
    else if (ph == 23) { type = 1; a0 = 1; a1 = 1; a2 = 2; }
    else if (ph == 24) { type = 6; a0 = 1; }
    else { type = 5; a0 = 3; }
}
template <int TYPE> DI void run_phase(const Params& P, int a0, int a1, int a2, LAS unsigned char* L) {
    unsigned char* ws = P.ws; const float* mod = (const float*)(ws + OFF_MOD);
    pg8::StaticOrder S;
    if constexpr (TYPE == 0) { mod_gemv(P, (LAS float*)L); rotary_tables(P); __syncthreads(); convert_set(P, 0, (LAS unsigned*)L); }
    else if constexpr (TYPE == 1) { if (a2 >= 0) convert_set(P, a2, (LAS unsigned*)L); norm_phase(P, a0, a1); }
    else if constexpr (TYPE == 2) { pg8::Gemm g{(const bf16_t*)(ws + OFF_H) + (size_t)a0 * 8192 * 2048, (const bf16_t*)(ws + OFF_WQKV0), 8192, 18432, 2048};
        S.init(g.M, g.N, gridDim.x, blockIdx.x); EpiPlainBf16 E{(bf16_t*)(ws + OFF_QKVC), 18432};
        pg8::gemm_phase<EpiPlainBf16, pg8::StaticOrder>(L, g, S, E); }
    else if constexpr (TYPE == 3) attn_phase(P, L);
    else if constexpr (TYPE == 4) merge_phase(P, a0);
    else if constexpr (TYPE == 5) {
        const size_t offA = a0 == 0 ? OFF_O : (a0 == 1 ? OFF_HID0 : (a0 == 2 ? OFF_RO : OFF_HID1));
        const size_t offB = a0 == 0 ? OFF_WO0 : (a0 == 1 ? OFF_WDN0 : (a0 == 2 ? OFF_WRO : OFF_WDN1));
        const int kk = a0 == 0 ? 2048 : (a0 == 2 ? 4096 : DFF);
        const int goff = ((a0 >= 2) ? 8 * MODW : 0) + ((a0 & 1) ? 5 * DM : 2 * DM);
        const float* rsd = a0 == 0 ? P.x : P.out;
        pg8::Gemm g{(const bf16_t*)(ws + offA), (const bf16_t*)(ws + offB), TTOK, DM, kk};
        EpiResid E{rsd, P.out, mod + goff};
        S.init(g.M, g.N, gridDim.x, blockIdx.x);
        pg8::gemm_phase<EpiResid, pg8::StaticOrder>(L, g, S, E); }
    else if constexpr (TYPE == 6) { pg8::Gemm g{(const bf16_t*)(ws + OFF_H), (const bf16_t*)(ws + (a0 ? OFF_WUP1 : OFF_WUP0)), TTOK, 2 * DFF, 2048};
        S.init(g.M, g.N, gridDim.x, blockIdx.x); EpiSwiGLU E{(bf16_t*)(ws + (a0 ? OFF_HID1 : OFF_HID0))};
        pg8::gemm_phase<EpiSwiGLU, pg8::StaticOrder>(L, g, S, E); }
    else if constexpr (TYPE == 7) { pg8::Gemm g{(const bf16_t*)(ws + OFF_H), (const bf16_t*)(ws + OFF_WRQKV), TTOK, 8192, 2048};
        S.init(g.M, g.N, gridDim.x, blockIdx.x);
        EpiRetQKV E{(bf16_t*)(ws + OFF_RQ), (bf16_t*)(ws + OFF_RK), (bf16_t*)(ws + OFF_RV), (const float*)(ws + OFF_COS), (const float*)(ws + OFF_SIN)};
        pg8::gemm_phase<EpiRetQKV, pg8::StaticOrder>(L, g, S, E); }
    else if constexpr (TYPE == 8) scan_phase(P, L);
    else { pg8::Gemm g{(const bf16_t*)(ws + OFF_H), (const bf16_t*)(ws + OFF_WRG), TTOK, 4096, 2048};
        S.init(g.M, g.N, gridDim.x, blockIdx.x); EpiRetGate E{(bf16_t*)(ws + OFF_RO), (const float*)(ws + OFF_SSQ)};
        pg8::gemm_phase<EpiRetGate, pg8::StaticOrder>(L, g, S, E); }
}
#ifndef ONE_LAUNCH
#define ONE_LAUNCH 0
#endif
#if !ONE_LAUNCH
template <int TYPE> __global__ void __launch_bounds__(NTHREADS, 2) k_phase(Params P, int a0, int a1, int a2) {
    extern __shared__ __attribute__((aligned(16))) unsigned char shm[];
    run_phase<TYPE>(P, a0, a1, a2, (LAS unsigned char*)shm);
}
template <int TYPE> static void launch_phase(const Params& p, int a0, int a1, int a2, int grid, hipStream_t stream) {
    static bool attr = false;
    if (!attr) { (void)hipFuncSetAttribute((const void*)k_phase<TYPE>, hipFuncAttributeMaxDynamicSharedMemorySize, LDS_BYTES); attr = true; }
    hipLaunchKernelGGL(k_phase<TYPE>, dim3(grid), dim3(NTHREADS), LDS_BYTES, stream, p, a0, a1, a2);
}
#endif

extern "C" void kernel_launch(void* const* d_in, const int* in_sizes, int n_in, void* d_out, int out_size, void* d_ws, size_t ws_size, hipStream_t stream) {
    static int grid = 0;
    if (grid == 0) {
        int dev = 0, cus = 0;
        (void)hipGetDevice(&dev);
        (void)hipDeviceGetAttribute(&cus, hipDeviceAttributeMultiprocessorCount, dev);
        grid = cus > 0 ? cus : 256;
        if (ws_size < WS_NEED) fprintf(stderr, "kernel_launch: workspace too small: %zu < %zu\n", ws_size, (size_t)WS_NEED);
    }
    Params p{};
    p.x = (const float*)d_in[0]; p.c = (const float*)d_in[1]; p.w_mod = (const float*)d_in[2]; p.b_mod = (const float*)d_in[3]; p.norm_mix = (const float*)d_in[4]; p.norm_ffn = (const float*)d_in[5];
    p.rel_bias = (const float*)d_in[6]; p.att_w_qkv = (const float*)d_in[7]; p.att_q_gain = (const float*)d_in[8]; p.att_k_gain = (const float*)d_in[9]; p.att_w_o = (const float*)d_in[10];
    p.ret_w_qkvg = (const float*)d_in[11]; p.ret_w_o = (const float*)d_in[12]; p.ffn_w_up = (const float*)d_in[13]; p.ffn_w_down = (const float*)d_in[14];
    p.out = (float*)d_out; p.ws = (unsigned char*)d_ws;
#if !ONE_LAUNCH
    for (int ph = 0; ph < MAXPH; ++ph) {
        int type, a0, a1, a2;
        { a0 = 0; a1 = 0; a2 = -1;
          if (ph == 0) type = 0; else if (ph == 1) type = 1; else if (ph < 14) { type = 2 + (ph - 2) % 3; a0 = (ph - 2) / 3; }
          else if (ph == 14) { type = 5; a0 = 0; } else if (ph == 15) { type = 1; a1 = 1; } else if (ph == 16) { type = 6; } else if (ph == 17) { type = 5; a0 = 1; }
          else if (ph == 18) { type = 1; a0 = 1; a2 = 1; } else if (ph == 19) type = 7; else if (ph == 20) type = 8; else if (ph == 21) type = 9;
          else if (ph == 22) { type = 5; a0 = 2; } else if (ph == 23) { type = 1; a0 = 1; a1 = 1; a2 = 2; } else if (ph == 24) { type = 6; a0 = 1; } else { type = 5; a0 = 3; } }
        switch (type) {
            case 0: launch_phase<0>(p, a0, a1, a2, grid, stream); break; case 1: launch_phase<1>(p, a0, a1, a2, grid, stream); break;
            case 2: launch_phase<2>(p, a0, a1, a2, grid, stream); break; case 3: launch_phase<3>(p, a0, a1, a2, grid, stream); break;
            case 4: launch_phase<4>(p, a0, a1, a2, grid, stream); break; case 5: launch_phase<5>(p, a0, a1, a2, grid, stream); break;
            case 6: launch_phase<6>(p, a0, a1, a2, grid, stream); break; case 7: launch_phase<7>(p, a0, a1, a2, grid, stream); break;
            case 8: launch_phase<8>(p, a0, a1, a2, grid, stream); break; default: launch_phase<9>(p, a0, a1, a2, grid, stream); break;
        }
    }
#endif
}
```

```cpp
#include <hip/hip_runtime.h>
#include <hip/hip_cooperative_groups.h>
#include <cstdio>
namespace cg = cooperative_groups;

#define LAS __attribute__((address_space(3)))
#define PG8_LAS LAS
typedef unsigned short bf16_t;
typedef short bf16x8 __attribute__((ext_vector_type(8)));
typedef float f32x4 __attribute__((ext_vector_type(4)));
typedef unsigned u32x4 __attribute__((ext_vector_type(4)));
typedef unsigned u32x2 __attribute__((ext_vector_type(2)));
#define DI __device__ __forceinline__

constexpr int TTOK = 32768, DM = 2048, SEQL = 4096, DFF = 5632, MODW = 12288;
constexpr float LOG2E = 1.4426950408889634f;
constexpr float NEPS = 1e-6f;
constexpr int LDS_BYTES = 163840;
constexpr int NTHREADS = 512;

constexpr size_t MB = 1048576;
constexpr size_t OFF_MOD = 0;
constexpr size_t OFF_COS = 1 * MB;
constexpr size_t OFF_SIN = 3 * MB;
constexpr size_t OFF_LSE = 5 * MB;
constexpr size_t OFF_SSQ = 8 * MB;
constexpr size_t OFF_BAR = 12 * MB;
constexpr size_t OFF_H   = 16 * MB;
constexpr size_t OFF_W   = 144 * MB;
constexpr size_t OFF_WQKV0 = OFF_W;
constexpr size_t OFF_WO0   = OFF_WQKV0 + 72 * MB;
constexpr size_t OFF_WUP0  = OFF_WO0 + 8 * MB;
constexpr size_t OFF_WDN0  = OFF_WUP0 + 44 * MB;
constexpr size_t OFF_BIG0  = OFF_WDN0 + 22 * MB;
constexpr size_t OFF_QKVC  = OFF_BIG0;
constexpr size_t OFF_OG    = OFF_QKVC + 288 * MB;
constexpr size_t OFF_O     = OFF_OG + 96 * MB;
constexpr size_t OFF_HID0  = OFF_BIG0;
constexpr size_t OFF_WRQKV = OFF_W;
constexpr size_t OFF_WRG   = OFF_WRQKV + 32 * MB;
constexpr size_t OFF_WRO   = OFF_WRG + 16 * MB;
constexpr size_t OFF_BIG1  = OFF_WRO + 16 * MB;
constexpr size_t OFF_RQ    = OFF_BIG1;
constexpr size_t OFF_RK    = OFF_RQ + 128 * MB;
constexpr size_t OFF_RV    = OFF_RK + 128 * MB;
constexpr size_t OFF_RO    = OFF_RV + 256 * MB;
constexpr size_t OFF_WUP1  = OFF_BIG1;
constexpr size_t OFF_WDN1  = OFF_WUP1 + 44 * MB;
constexpr size_t OFF_HID1  = OFF_WDN1 + 22 * MB;
constexpr size_t WS_NEED   = OFF_RO + 256 * MB;

struct Params {
    const float *x, *c, *w_mod, *b_mod, *norm_mix, *norm_ffn, *rel_bias, *att_w_qkv, *att_q_gain, *att_k_gain, *att_w_o, *ret_w_qkvg, *ret_w_o, *ffn_w_up, *ffn_w_down;
    float* out; unsigned char* ws;
};

DI unsigned cvt_pk_bf16(float lo, float hi) { unsigned r; asm volatile("v_cvt_pk_bf16_f32 %0, %1, %2" : "=v"(r) : "v"(lo), "v"(hi)); return r; }
DI float bf_lo(unsigned u) { return __uint_as_float(u << 16); }
DI float bf_hi(unsigned u) { return __uint_as_float(u & 0xffff0000u); }
DI float silu_f(float v) { return v * __builtin_amdgcn_rcpf(1.0f + __expf(-v)); }
DI float shx(float v, int m) { return __shfl_xor(v, m); }
DI int tidx() { int t = threadIdx.x; asm volatile("" : "+v"(t)); return t; }
DI int bidx() { int b = blockIdx.x; asm volatile("" : "+s"(b)); return b; }

namespace pg8 {
constexpr int BM = 256, BK = 64, HALF = 128, HTB = HALF * BK * 2, STAGE_BYTES = 8 * HTB, NXCD = 8, WGM = 8;
__host__ __device__ __forceinline__ int lds_byte(int r, int c) { const int st = (r >> 4) * 2 + (c >> 5), rr = r & 15, cc = c & 31, ob = rr * 64 + cc * 2; return st * 1024 + (ob ^ (((ob >> 9) & 1) << 5)); }
__host__ __device__ __forceinline__ void stage_rc(int b, int& R, int& C) { const int st = b / 1024, sb = b % 1024, swz = sb ^ (((sb >> 9) & 1) << 5); R = (st >> 1) * 16 + swz / 64; C = (st & 1) * 32 + (swz % 64) / 2; }
__host__ __device__ __forceinline__ int perm32(int rho) { const int n = rho >> 4, i = rho & 15; return 8 * (i >> 2) + 4 * n + (i & 3); }
struct Unit { int pm, pn; };
struct Gemm { const bf16_t* A; const bf16_t* Bt; int M, N, K; };
struct StaticOrder {
    int nM, nN, nwg, G, c, wgm;
    __device__ void init(int M, int N, int G_, int c_, int wgm_ = WGM) { nM = M / BM; nN = N / BM; nwg = nM * nN; G = G_; c = c_; wgm = wgm_; }
    __device__ bool next(int i, Unit& u) const {
        const long L = (long)i * G + c; if (L >= nwg) return false;
        int wgid = (int)L; { const int q = nwg / NXCD, r = nwg % NXCD, xcd = wgid % NXCD, off = wgid / NXCD; wgid = (xcd < r ? xcd * (q + 1) : r * (q + 1) + (xcd - r) * q) + off; }
        const int nig = wgm * nN, gid = wgid / nig, fm = gid * wgm, gsz = (nM - fm) < wgm ? (nM - fm) : wgm;
        u.pm = fm + ((wgid % nig) % gsz); u.pn = (wgid % nig) / gsz; return true;
    }
    __device__ __forceinline__ void a_ready(const Unit&) const {}
    __device__ __forceinline__ void done(const Unit&) const {}
};
template <class Epi, class Sched>
__device__ __forceinline__ void gemm_phase(PG8_LAS unsigned char* lds, const Gemm g, const Sched& S, const Epi& E) {
    const int tid = tidx(), wid = __builtin_amdgcn_readfirstlane(tid >> 6), lane = tid & 63, wr = wid >> 2, wc = wid & 3, fr = lane & 15, fq = lane >> 4;
    const int K = g.K, nt = K / BK;
    unsigned voffA[2], voffB[2];
#pragma unroll
    for (int i = 0; i < 2; ++i) { int R, C; stage_rc(tid * 16 + i * 8192, R, C); const int Rb = Epi::PERM ? ((R & ~31) + perm32(R & 31)) : R;
        voffA[i] = (unsigned)(R * K + C) * 2u; voffB[i] = (unsigned)(Rb * K + C) * 2u; }
    const size_t kstep = (size_t)(BK * 2);
    const size_t hstep = (size_t)HALF * K * 2;
    const size_t tstep = 2 * hstep;
    const unsigned ldsw = (unsigned)wid * 1024u;
    const int aoff = lds_byte(wr * 64 + fr, fq * 8), boff = lds_byte(wc * 32 + fr, fq * 8);
#define PG8_SA(b, h) (((b) * 2 + (h)) * HTB)
#define PG8_SB(b, h) ((4 + (b) * 2 + (h)) * HTB)
#define PG8_STAGE(bufoff, gbase, voff) do { _Pragma("unroll") for (int _i = 0; _i < 2; ++_i) \
        __builtin_amdgcn_global_load_lds((const unsigned*)((const char*)(gbase) + (voff)[_i]), (PG8_LAS unsigned*)(lds + (bufoff) + ldsw + _i * 8192), 16, 0, 0); } while (0)
#define PG8_LDA(dst, b, h) do { _Pragma("unroll") for (int m = 0; m < 4; ++m) _Pragma("unroll") for (int k = 0; k < 2; ++k) dst[m][k] = *(const PG8_LAS bf16x8*)(lds + PG8_SA(b, h) + aoff + m * 2048 + k * 1024); } while (0)
#define PG8_LDB(dst, b, h) do { _Pragma("unroll") for (int n = 0; n < 2; ++n) _Pragma("unroll") for (int k = 0; k < 2; ++k) dst[n][k] = *(const PG8_LAS bf16x8*)(lds + PG8_SB(b, h) + boff + n * 2048 + k * 1024); } while (0)
#define PG8_MMA(ai, bj, At, Bt) do { __builtin_amdgcn_s_setprio(1); _Pragma("unroll") for (int m = 0; m < 4; ++m) _Pragma("unroll") for (int n = 0; n < 2; ++n) _Pragma("unroll") for (int k = 0; k < 2; ++k) \
        acc[ai][bj][m][n] = __builtin_amdgcn_mfma_f32_16x16x32_bf16(Bt[n][k], At[m][k], acc[ai][bj][m][n], 0, 0, 0); __builtin_amdgcn_s_setprio(0); } while (0)
#define PG8_WAIT_V(n) asm volatile("s_waitcnt vmcnt(" #n ")" ::: "memory")
#define PG8_WAIT_L(n) asm volatile("s_waitcnt lgkmcnt(" #n ")" ::: "memory")
#define PG8_BAR __builtin_amdgcn_s_barrier()
#define PG8_SCHED __builtin_amdgcn_sched_barrier(0)
    Unit cur, nxt; int ui = 0;
    if (!S.next(0, cur)) return;
    f32x4 acc[2][2][4][2];
#pragma unroll
    for (int a = 0; a < 2; ++a)
#pragma unroll
        for (int b = 0; b < 2; ++b)
#pragma unroll
            for (int m = 0; m < 4; ++m)
#pragma unroll
                for (int n = 0; n < 2; ++n) acc[a][b][m][n] = (f32x4){0.f, 0.f, 0.f, 0.f};
    bf16x8 At[4][2], B0[2][2], B1[2][2];
    const char* cA = (const char*)g.A + (size_t)cur.pm * tstep; const char* cB = (const char*)g.Bt + (size_t)cur.pn * tstep;
    S.a_ready(cur);
    PG8_STAGE(PG8_SB(0, 0), cB, voffB); PG8_STAGE(PG8_SA(0, 0), cA, voffA); PG8_STAGE(PG8_SB(0, 1), cB + hstep, voffB); PG8_STAGE(PG8_SA(0, 1), cA + hstep, voffA);
    if (wr == 1) PG8_BAR;
    PG8_WAIT_V(4); PG8_BAR;
    PG8_STAGE(PG8_SB(1, 0), cB + kstep, voffB); PG8_STAGE(PG8_SA(1, 0), cA + kstep, voffA); PG8_STAGE(PG8_SB(1, 1), cB + hstep + kstep, voffB);
    PG8_WAIT_V(6); PG8_BAR;
    for (;;) {
        const bool has_next = S.next(ui + 1, nxt);
        const char* nA = has_next ? (const char*)g.A + (size_t)nxt.pm * tstep : cA; const char* nB = has_next ? (const char*)g.Bt + (size_t)nxt.pn * tstep : cB;
        for (int t = 0; t < nt; t += 2) {
            const bool last = (t == nt - 2);
            const char* a1 = cA + (size_t)(t + 1) * kstep;
            const char* a2 = last ? nA : cA + (size_t)(t + 2) * kstep; const char* b2 = last ? nB : cB + (size_t)(t + 2) * kstep;
            const char* a3 = a2 + kstep; const char* b3 = b2 + kstep;
            if (last && has_next) S.a_ready(nxt);
            PG8_LDB(B0, 0, 0); PG8_SCHED; PG8_LDA(At, 0, 0); PG8_STAGE(PG8_SA(1, 1), a1 + hstep, voffA);
            PG8_WAIT_L(8); PG8_BAR; PG8_WAIT_L(0); PG8_MMA(0, 0, At, B0); PG8_BAR; PG8_SCHED;
            PG8_LDB(B1, 0, 1); PG8_STAGE(PG8_SB(0, 0), b2, voffB);
            PG8_BAR; PG8_WAIT_L(0); PG8_MMA(0, 1, At, B1); PG8_BAR;
            PG8_LDA(At, 0, 1); PG8_STAGE(PG8_SA(0, 0), a2, voffA);
            PG8_BAR; PG8_WAIT_L(0); PG8_MMA(1, 0, At, B0); PG8_BAR; PG8_SCHED;
            PG8_STAGE(PG8_SB(0, 1), b2 + hstep, voffB);
            PG8_WAIT_V(6); PG8_BAR; PG8_MMA(1, 1, At, B1); PG8_BAR;
            PG8_LDB(B0, 1, 0); PG8_SCHED; PG8_LDA(At, 1, 0); PG8_STAGE(PG8_SA(0, 1), a2 + hstep, voffA);
            PG8_WAIT_L(8); PG8_BAR; PG8_WAIT_L(0); PG8_MMA(0, 0, At, B0); PG8_BAR; PG8_SCHED;
            PG8_LDB(B1, 1, 1); PG8_STAGE(PG8_SB(1, 0), b3, voffB);
            PG8_BAR; PG8_WAIT_L(0); PG8_MMA(0, 1, At, B1); PG8_BAR;
            PG8_LDA(At, 1, 1); PG8_STAGE(PG8_SA(1, 0), a3, voffA);
            PG8_BAR; PG8_WAIT_L(0); PG8_MMA(1, 0, At, B0); PG8_BAR; PG8_SCHED;
            PG8_STAGE(PG8_SB(1, 1), b3 + hstep, voffB);
            PG8_WAIT_V(6); PG8_BAR; PG8_MMA(1, 1, At, B1); PG8_BAR;
        }
        E(acc, cur, wr, wc, fr, fq); S.done(cur);
        if (!has_next) break;
#pragma unroll
        for (int a = 0; a < 2; ++a)
#pragma unroll
            for (int b = 0; b < 2; ++b)
#pragma unroll
                for (int m = 0; m < 4; ++m)
#pragma unroll
                    for (int n = 0; n < 2; ++n) acc[a][b][m][n] = (f32x4){0.f, 0.f, 0.f, 0.f};
        cur = nxt; cA = nA; cB = nB; ++ui;
    }
    PG8_WAIT_V(0);
    if (wr == 0) PG8_BAR;
    PG8_BAR;
#undef PG8_SA
#undef PG8_SB
#undef PG8_STAGE
#undef PG8_LDA
#undef PG8_LDB
#undef PG8_MMA
#undef PG8_WAIT_V
#undef PG8_WAIT_L
#undef PG8_BAR
#undef PG8_SCHED
}
}
using pg8::Unit;
typedef f32x4 AccT[2][2][4][2];

struct EpiPlainBf16 {
    static constexpr bool PERM = true;
    bf16_t* O; int ldc;
    DI void operator()(const AccT& acc, const Unit& u, int wr, int wc, int fr, int fq) const {
        const int row0 = u.pm * 256 + wr * 64 + fr, col0 = u.pn * 256 + wc * 32 + 8 * fq;
#pragma unroll
        for (int ai = 0; ai < 2; ++ai)
#pragma unroll
            for (int m = 0; m < 4; ++m) { bf16_t* rowp = O + (size_t)(row0 + ai * 128 + m * 16) * ldc + col0;
#pragma unroll
                for (int bj = 0; bj < 2; ++bj) { const f32x4 v0 = acc[ai][bj][m][0], v1 = acc[ai][bj][m][1];
                    u32x4 w; w.x = cvt_pk_bf16(v0[0], v0[1]); w.y = cvt_pk_bf16(v0[2], v0[3]); w.z = cvt_pk_bf16(v1[0], v1[1]); w.w = cvt_pk_bf16(v1[2], v1[3]);
                    *(u32x4*)(rowp + bj * 128) = w; } }
    }
};
struct EpiResid {
    static constexpr bool PERM = false;
    const float* R; float* O; const float* gate;
    DI void operator()(const AccT& acc, const Unit& u, int wr, int wc, int fr, int fq) const {
        const int row0 = u.pm * 256 + wr * 64 + fr, col0 = u.pn * 256 + wc * 32 + 4 * fq;
        const int b = (u.pm * 256) >> 12;
        f32x4 gv[2][2];
#pragma unroll
        for (int bj = 0; bj < 2; ++bj)
#pragma unroll
            for (int n = 0; n < 2; ++n) gv[bj][n] = *(const f32x4*)(gate + (size_t)b * MODW + col0 + bj * 128 + n * 16);
#pragma unroll
        for (int ai = 0; ai < 2; ++ai)
#pragma unroll
            for (int mp = 0; mp < 2; ++mp) {
                f32x4 rv[2][2][2];
#pragma unroll
                for (int mm = 0; mm < 2; ++mm) { const size_t ro = (size_t)(row0 + ai * 128 + (2 * mp + mm) * 16) * DM + col0;
#pragma unroll
                    for (int bj = 0; bj < 2; ++bj)
#pragma unroll
                        for (int n = 0; n < 2; ++n) rv[mm][bj][n] = *(const f32x4*)(R + ro + bj * 128 + n * 16); }
#pragma unroll
                for (int mm = 0; mm < 2; ++mm) { const size_t ro = (size_t)(row0 + ai * 128 + (2 * mp + mm) * 16) * DM + col0;
#pragma unroll
                    for (int bj = 0; bj < 2; ++bj)
#pragma unroll
                        for (int n = 0; n < 2; ++n) *(f32x4*)(O + ro + bj * 128 + n * 16) = rv[mm][bj][n] + gv[bj][n] * acc[ai][bj][2 * mp + mm][n]; }
            }
    }
};
struct EpiSwiGLU {
    static constexpr bool PERM = true;
    bf16_t* O;
    DI void operator()(const AccT& acc, const Unit& u, int wr, int wc, int fr, int fq) const {
        const int row0 = u.pm * 256 + wr * 64 + fr, col0 = u.pn * 128 + wc * 32 + 8 * fq;
#pragma unroll
        for (int ai = 0; ai < 2; ++ai)
#pragma unroll
            for (int m = 0; m < 4; ++m) { bf16_t* rowp = O + (size_t)(row0 + ai * 128 + m * 16) * DFF + col0;
                float r[8];
#pragma unroll
                for (int n = 0; n < 2; ++n)
#pragma unroll
                    for (int e = 0; e < 4; ++e) r[n * 4 + e] = silu_f(acc[ai][0][m][n][e]) * acc[ai][1][m][n][e];
                u32x4 w; w.x = cvt_pk_bf16(r[0], r[1]); w.y = cvt_pk_bf16(r[2], r[3]); w.z = cvt_pk_bf16(r[4], r[5]); w.w = cvt_pk_bf16(r[6], r[7]);
                *(u32x4*)rowp = w; }
    }
};
struct EpiRetQKV {
    static constexpr bool PERM = true;
    bf16_t *Q, *Kt, *V; const float *cosT, *sinT;
    DI void operator()(const AccT& acc, const Unit& u, int wr, int wc, int fr, int fq) const {
        const int row0 = u.pm * 256 + wr * 64 + fr, i0 = wc * 32 + 8 * fq;
        if (u.pn >= 16) {
#pragma unroll
            for (int ai = 0; ai < 2; ++ai)
#pragma unroll
                for (int m = 0; m < 4; ++m) { bf16_t* rowp = V + (size_t)(row0 + ai * 128 + m * 16) * 4096 + (u.pn - 16) * 256 + i0;
#pragma unroll
                    for (int bj = 0; bj < 2; ++bj) { const f32x4 v0 = acc[ai][bj][m][0], v1 = acc[ai][bj][m][1];
                        u32x4 w; w.x = cvt_pk_bf16(v0[0], v0[1]); w.y = cvt_pk_bf16(v0[2], v0[3]); w.z = cvt_pk_bf16(v1[0], v1[1]); w.w = cvt_pk_bf16(v1[2], v1[3]);
                        *(u32x4*)(rowp + bj * 128) = w; } }
            return;
        }
        const bool isk = u.pn >= 8; const int hd = u.pn & 7;
        bf16_t* dst = (isk ? Kt : Q) + hd * 256 + i0;
        const float l2g = __log2f(1.0f - exp2f(-5.0f - (float)hd));
#pragma unroll
        for (int ai = 0; ai < 2; ++ai) {
            f32x4 cvs[4][2], svs[4][2];
#pragma unroll
            for (int m = 0; m < 4; ++m) { const int s = (row0 + ai * 128 + m * 16) & 4095;
#pragma unroll
                for (int n = 0; n < 2; ++n) { cvs[m][n] = *(const f32x4*)(cosT + s * 128 + i0 + n * 4); svs[m][n] = *(const f32x4*)(sinT + s * 128 + i0 + n * 4); } }
#pragma unroll
            for (int m = 0; m < 4; ++m) { const int row = row0 + ai * 128 + m * 16; const int s = row & 4095;
                const float sc = isk ? 0.0625f * exp2f(-(float)((s & 127) + 1) * l2g) : 1.0f;
                float o1[8], o2[8];
#pragma unroll
                for (int n = 0; n < 2; ++n) { const f32x4 cv = cvs[m][n], sv = svs[m][n];
                    const f32x4 t1 = acc[ai][0][m][n], t2 = acc[ai][1][m][n];
#pragma unroll
                    for (int e = 0; e < 4; ++e) { o1[n * 4 + e] = (t1[e] * cv[e] - t2[e] * sv[e]) * sc; o2[n * 4 + e] = (t1[e] * sv[e] + t2[e] * cv[e]) * sc; } }
                u32x4 w1, w2;
                w1.x = cvt_pk_bf16(o1[0], o1[1]); w1.y = cvt_pk_bf16(o1[2], o1[3]); w1.z = cvt_pk_bf16(o1[4], o1[5]); w1.w = cvt_pk_bf16(o1[6], o1[7]);
                w2.x = cvt_pk_bf16(o2[0], o2[1]); w2.y = cvt_pk_bf16(o2[2], o2[3]); w2.z = cvt_pk_bf16(o2[4], o2[5]); w2.w = cvt_pk_bf16(o2[6], o2[7]);
                bf16_t* rp = dst + (size_t)row * 2048;
                *(u32x4*)rp = w1; *(u32x4*)(rp + 128) = w2; }
        }
    }
};
struct EpiRetGate {
    static constexpr bool PERM = true;
    bf16_t* RO; const float* ssq;
    DI void operator()(const AccT& acc, const Unit& u, int wr, int wc, int fr, int fq) const {
        const int row0 = u.pm * 256 + wr * 64 + fr, col0 = u.pn * 256 + wc * 32 + 8 * fq, hd = u.pn >> 1;
#pragma unroll
        for (int ai = 0; ai < 2; ++ai) {
            f32x4 sq[4]; u32x4 ov[4][2];
#pragma unroll
            for (int m = 0; m < 4; ++m) { const int row = row0 + ai * 128 + m * 16; sq[m] = *(const f32x4*)(ssq + (size_t)row * 32 + hd * 4);
                const bf16_t* rowp = RO + (size_t)row * 4096 + col0; ov[m][0] = *(const u32x4*)rowp; ov[m][1] = *(const u32x4*)(rowp + 128); }
#pragma unroll
            for (int m = 0; m < 4; ++m) { const int row = row0 + ai * 128 + m * 16;
                const float rn = rsqrtf((sq[m][0] + sq[m][1] + sq[m][2] + sq[m][3]) * (1.0f / 512.0f) + NEPS);
                bf16_t* rowp = RO + (size_t)row * 4096 + col0;
#pragma unroll
                for (int bj = 0; bj < 2; ++bj) { const u32x4 o = ov[m][bj];
                    const f32x4 g0 = acc[ai][bj][m][0], g1 = acc[ai][bj][m][1];
                    u32x4 w;
                    w.x = cvt_pk_bf16(silu_f(g0[0]) * bf_lo(o.x) * rn, silu_f(g0[1]) * bf_hi(o.x) * rn);
                    w.y = cvt_pk_bf16(silu_f(g0[2]) * bf_lo(o.y) * rn, silu_f(g0[3]) * bf_hi(o.y) * rn);
                    w.z = cvt_pk_bf16(silu_f(g1[0]) * bf_lo(o.z) * rn, silu_f(g1[1]) * bf_hi(o.z) * rn);
                    w.w = cvt_pk_bf16(silu_f(g1[2]) * bf_lo(o.w) * rn, silu_f(g1[3]) * bf_hi(o.w) * rn);
                    *(u32x4*)(rowp + bj * 128) = w; } }
        }
    }
};

struct CJob { const float* src; bf16_t* dst; int ldsrc, K, nrows, mode, coff; };
DI void convert_w(const CJob j, LAS unsigned* lw) {
    const int tid = tidx(), ntR = j.nrows >> 6, ntK = j.K >> 7, total = ntR * ntK;
    const int nq = tid & 15, kr = tid >> 4;
    auto tile_src = [&](int tile) -> const float* { const int rt = tile % ntR, kt = tile / ntR, R0 = rt * 64, k0 = kt * 128;
        const int c0 = j.mode == 0 ? j.coff + R0 : ((R0 >> 7) & 1) * DFF + (R0 >> 8) * 128 + (R0 & 127);
        return j.src + (size_t)(k0 + 2 * kr) * j.ldsrc + c0 + 4 * nq; };
    f32x4 a[2][2], an[2][2];
    int tile = bidx();
    if (tile < total) { const float* sp = tile_src(tile);
#pragma unroll
        for (int p = 0; p < 2; ++p) { const float* s = sp + (size_t)(64 * p) * j.ldsrc; a[p][0] = *(const f32x4*)s; a[p][1] = *(const f32x4*)(s + j.ldsrc); } }
    for (; tile < total; tile += gridDim.x) {
        const int rt = tile % ntR, kt = tile / ntR, R0 = rt * 64, k0 = kt * 128;
        { const int tnext = tile + gridDim.x; const float* sp = tile_src(tnext < total ? tnext : tile);
#pragma unroll
            for (int p = 0; p < 2; ++p) { const float* s = sp + (size_t)(64 * p) * j.ldsrc; an[p][0] = *(const f32x4*)s; an[p][1] = *(const f32x4*)(s + j.ldsrc); } }
#pragma unroll
        for (int p = 0; p < 2; ++p) { const int kp = p * 32 + kr;
#pragma unroll
            for (int e = 0; e < 4; ++e) lw[(4 * nq + e) * 65 + kp] = cvt_pk_bf16(a[p][0][e], a[p][1][e]); }
        __syncthreads();
#pragma unroll
        for (int i = 0; i < 2; ++i) { const int idx = tid + 512 * i, n = idx >> 4, ch = idx & 15;
            u32x4 v; v.x = lw[n * 65 + 4 * ch]; v.y = lw[n * 65 + 4 * ch + 1]; v.z = lw[n * 65 + 4 * ch + 2]; v.w = lw[n * 65 + 4 * ch + 3];
            *(u32x4*)(j.dst + (size_t)(R0 + n) * j.K + k0 + 8 * ch) = v; }
        __syncthreads();
#pragma unroll
        for (int p = 0; p < 2; ++p) { a[p][0] = an[p][0]; a[p][1] = an[p][1]; }
    }
}
DI void convert_set(const Params& P, int set, LAS unsigned* lw) {
    const int njobs = set == 0 ? 4 : (set == 1 ? 3 : 2);
    for (int ji = 0; ji < njobs; ++ji) {
        CJob j;
        const int id = set * 4 + ji;
        switch (id) {
            case 0:  j = CJob{P.att_w_qkv, (bf16_t*)(P.ws + OFF_WQKV0), 18432, 2048, 18432, 0, 0}; break;
            case 1:  j = CJob{P.att_w_o, (bf16_t*)(P.ws + OFF_WO0), 2048, 2048, 2048, 0, 0}; break;
            case 2:  j = CJob{P.ffn_w_up, (bf16_t*)(P.ws + OFF_WUP0), 11264, 2048, 11264, 1, 0}; break;
            case 3:  j = CJob{P.ffn_w_down, (bf16_t*)(P.ws + OFF_WDN0), 2048, 5632, 2048, 0, 0}; break;
            case 4:  j = CJob{P.ret_w_qkvg, (bf16_t*)(P.ws + OFF_WRQKV), 12288, 2048, 8192, 0, 0}; break;
            case 5:  j = CJob{P.ret_w_qkvg, (bf16_t*)(P.ws + OFF_WRG), 12288, 2048, 4096, 0, 8192}; break;
            case 6:  j = CJob{P.ret_w_o, (bf16_t*)(P.ws + OFF_WRO), 2048, 4096, 2048, 0, 0}; break;
            case 8:  j = CJob{P.ffn_w_up + (size_t)2048 * 11264, (bf16_t*)(P.ws + OFF_WUP1), 11264, 2048, 11264, 1, 0}; break;
            default: j = CJob{P.ffn_w_down + (size_t)5632 * 2048, (bf16_t*)(P.ws + OFF_WDN1), 2048, 5632, 2048, 0, 0}; break;
        }
        convert_w(j, lw);
    }
}

DI void mod_gemv(const Params& P, LAS float* lf) {
    const int tid = tidx();
    if (bidx() >= 192) return;
    for (int i = tid; i < 8 * 2048; i += NTHREADS) lf[i] = silu_f(P.c[i]);
    __syncthreads();
    LAS float* red = lf + 16384;
    float* mod = (float*)(P.ws + OFF_MOD);
    const int cq = tid & 31, kg = tid >> 5;
    for (int item = bidx(); item < 192; item += gridDim.x) {
        const int l = item / 96, nb = item % 96;
        const float* w = P.w_mod + ((size_t)l * 2048 + kg * 128) * MODW + nb * 128 + cq * 4;
        f32x4 acc[8];
#pragma unroll
        for (int b = 0; b < 8; ++b) acc[b] = (f32x4){0.f, 0.f, 0.f, 0.f};
        const LAS float* cs = lf + kg * 128;
#pragma unroll 1
        for (int k0 = 0; k0 < 128; k0 += 8) {
            f32x4 wv[8];
#pragma unroll
            for (int kk = 0; kk < 8; ++kk) wv[kk] = *(const f32x4*)(w + (size_t)(k0 + kk) * MODW);
#pragma unroll
            for (int kk = 0; kk < 8; ++kk)
#pragma unroll
                for (int b = 0; b < 8; ++b) acc[b] += wv[kk] * cs[b * 2048 + k0 + kk];
        }
#pragma unroll
        for (int b = 0; b < 8; ++b) *(LAS f32x4*)(red + (kg * 8 + b) * 128 + cq * 4) = acc[b];
        __syncthreads();
        for (int i = tid; i < 1024; i += NTHREADS) { const int b = i >> 7, cc = i & 127;
            float sum = 0.f;
#pragma unroll
            for (int g = 0; g < 16; ++g) sum += red[(g * 8 + b) * 128 + cc];
            mod[(size_t)(l * 8 + b) * MODW + nb * 128 + cc] = sum + P.b_mod[l * MODW + nb * 128 + cc]; }
        __syncthreads();
    }
}
DI void rotary_tables(const Params& P) {
    float* cosT = (float*)(P.ws + OFF_COS); float* sinT = (float*)(P.ws + OFF_SIN);
    for (int i = bidx() * NTHREADS + tidx(); i < 4096 * 128; i += gridDim.x * NTHREADS) {
        const int s = i >> 7, jx = i & 127;
        const float inv = 1.0f / exp2f((float)jx * (13.287712379549449f / 127.0f));
        const float ang = (float)s * inv;
        const float nn = rintf(ang * 0.15915494309189535f);
        float r = fmaf(-nn, 6.2831854820251465f, ang); r = fmaf(-nn, -1.7484555e-07f, r);
        cosT[i] = __cosf(r); sinT[i] = __sinf(r);
    }
}

DI void norm_phase(const Params& P, int l, int which) {
    const float* src = (l == 0 && which == 0) ? P.x : P.out;
    const float* gain = (which ? P.norm_ffn : P.norm_mix) + l * DM;
    const float* mod = (const float*)(P.ws + OFF_MOD) + (size_t)l * 8 * MODW;
    bf16_t* H = (bf16_t*)(P.ws + OFF_H);
    const int lane = tidx() & 63, gw = bidx() * 8 + (tidx() >> 6), nw = gridDim.x * 8;
    for (int blk = gw; blk < TTOK / 16; blk += nw) {
        const int rbase = blk * 16, b = rbase >> 12;
        const float* sh = mod + (size_t)b * MODW + (which ? 3 : 0) * DM; const float* sc = mod + (size_t)b * MODW + (which ? 4 : 1) * DM;
        f32x4 av[8], hv[8];
#pragma unroll
        for (int i = 0; i < 8; ++i) { const int cc = 4 * lane + 256 * i; const f32x4 gv = *(const f32x4*)(gain + cc), sv = *(const f32x4*)(sc + cc); hv[i] = *(const f32x4*)(sh + cc);
#pragma unroll
            for (int e = 0; e < 4; ++e) av[i][e] = gv[e] * (1.0f + sv[e]); }
#pragma unroll 1
        for (int rp = 0; rp < 8; ++rp) {
            const int row0 = rbase + 2 * rp;
            const float* xr = src + (size_t)row0 * DM;
            f32x4 v[2][8]; float ss0 = 0.f, ss1 = 0.f;
#pragma unroll
            for (int i = 0; i < 8; ++i) { v[0][i] = *(const f32x4*)(xr + 4 * lane + 256 * i); v[1][i] = *(const f32x4*)(xr + DM + 4 * lane + 256 * i); }
#pragma unroll
            for (int i = 0; i < 8; ++i) { ss0 += v[0][i][0] * v[0][i][0] + v[0][i][1] * v[0][i][1] + v[0][i][2] * v[0][i][2] + v[0][i][3] * v[0][i][3];
                ss1 += v[1][i][0] * v[1][i][0] + v[1][i][1] * v[1][i][1] + v[1][i][2] * v[1][i][2] + v[1][i][3] * v[1][i][3]; }
            ss0 += shx(ss0, 1); ss1 += shx(ss1, 1); ss0 += shx(ss0, 2); ss1 += shx(ss1, 2); ss0 += shx(ss0, 4); ss1 += shx(ss1, 4);
            ss0 += shx(ss0, 8); ss1 += shx(ss1, 8); ss0 += shx(ss0, 16); ss1 += shx(ss1, 16); ss0 += shx(ss0, 32); ss1 += shx(ss1, 32);
            const float rs0 = rsqrtf(ss0 * (1.0f / 2048.0f) + NEPS), rs1 = rsqrtf(ss1 * (1.0f / 2048.0f) + NEPS);
            bf16_t* hr = H + (size_t)row0 * DM;
#pragma unroll
            for (int i = 0; i < 8; ++i) { const int cc = 4 * lane + 256 * i;
                f32x4 o0, o1;
#pragma unroll
                for (int e = 0; e < 4; ++e) { o0[e] = v[0][i][e] * rs0 * av[i][e] + hv[i][e]; o1[e] = v[1][i][e] * rs1 * av[i][e] + hv[i][e]; }
                u32x2 w0, w1; w0.x = cvt_pk_bf16(o0[0], o0[1]); w0.y = cvt_pk_bf16(o0[2], o0[3]); w1.x = cvt_pk_bf16(o1[0], o1[1]); w1.y = cvt_pk_bf16(o1[2], o1[3]);
                *(u32x2*)(hr + cc) = w0; *(u32x2*)(hr + DM + cc) = w1; }
        }
    }
}
DI int t5_bucket(int dist) {
    if (dist < 16) return dist;
    const float v = logf((float)dist / 16.0f) / 4.852030263919617f * 16.0f;
    const int lg = 16 + (int)v;
    return lg < 31 ? lg : 31;
}
#define MFMA16(a, b, c) __builtin_amdgcn_mfma_f32_16x16x32_bf16((a), (b), (c), 0, 0, 0)
DI bf16x8 gather_col(const LAS unsigned char* p0, const LAS unsigned char* p1, int stride) {
    bf16x8 r;
    r[0] = *(const LAS short*)(p0); r[1] = *(const LAS short*)(p0 + stride); r[2] = *(const LAS short*)(p0 + 2 * stride); r[3] = *(const LAS short*)(p0 + 3 * stride);
    r[4] = *(const LAS short*)(p1); r[5] = *(const LAS short*)(p1 + stride); r[6] = *(const LAS short*)(p1 + 2 * stride); r[7] = *(const LAS short*)(p1 + 3 * stride);
    return r;
}
typedef short s16x4 __attribute__((ext_vector_type(4)));
DI bf16x8 tr_frag(const LAS unsigned char* p0, const LAS unsigned char* p1) {
    const s16x4 lo = __builtin_amdgcn_ds_read_tr16_b64_v4i16((LAS s16x4*)p0), hi = __builtin_amdgcn_ds_read_tr16_b64_v4i16((LAS s16x4*)p1);
    return __builtin_shufflevector(lo, hi, 0, 1, 2, 3, 4, 5, 6, 7);
}
DI bf16x8 pack8(const float* f) { u32x4 w; w.x = cvt_pk_bf16(f[0], f[1]); w.y = cvt_pk_bf16(f[2], f[3]); w.z = cvt_pk_bf16(f[4], f[5]); w.w = cvt_pk_bf16(f[6], f[7]); return __builtin_bit_cast(bf16x8, w); }

#define ATT_RAW_BAR() do { asm volatile("s_waitcnt lgkmcnt(0)" ::: "memory"); __builtin_amdgcn_s_barrier(); asm volatile("" ::: "memory"); } while (0)
DI void attn_phase(const Params& P, LAS unsigned char* L) {
    const bf16_t* QKV = (const bf16_t*)(P.ws + OFF_QKVC);
    bf16_t* OG = (bf16_t*)(P.ws + OFF_OG); float* LSE = (float*)(P.ws + OFF_LSE);
    const int tid = tidx(), lane = tid & 63, w = __builtin_amdgcn_readfirstlane(tid >> 6), fr = lane & 15, fq = lane >> 4;
    LAS unsigned char* Ks = L; LAS unsigned char* Vs = L + 65536; LAS float* biasL = (LAS float*)(L + 131072);
    const int ch = tid & 15, krow = tid >> 4;
    int vtr[8];
#pragma unroll
    for (int dt = 0; dt < 8; ++dt) vtr[dt] = (4 * fq + (fr >> 2)) * 256 + ((dt ^ (4 * (fq & 1) + (fr >> 2))) << 5) + (fr & 3) * 8;
    for (int sg = bidx(); sg < 768; sg += gridDim.x) {
        const int it0 = (767 - sg) * 4;
        const int blk0 = it0 & 31, h = (it0 >> 5) & 15, gb = it0 >> 9, g = gb % 3, bb = gb / 3;
        const int l2d = 2 * g, dil = 1 << l2d, nbl2 = 5 - l2d, nbm = (32 >> l2d) - 1;
        const size_t rowbase = (size_t)bb * 4096;
        const int colq = g * 6144 + h * 128;
        const bf16_t* qkv_c = QKV + colq;
        const f32x4 kg0 = *(const f32x4*)(P.att_k_gain + g * 128 + ch * 8), kg1 = *(const f32x4*)(P.att_k_gain + g * 128 + ch * 8 + 4);
        u32x4 ka[4], va[4], qraw[4], qnext[4];
        auto load_block = [&](int r_, int n_) {
#pragma unroll
            for (int i = 0; i < 4; ++i) { const int idx = n_ * 128 + krow + 32 * i;
                const bf16_t* p = qkv_c + (rowbase + (size_t)idx * dil + r_) * 18432 + ch * 8; ka[i] = *(const u32x4*)(p + 2048); va[i] = *(const u32x4*)(p + 4096); } };
        auto stage_block = [&](int half) {
#pragma unroll
            for (int i = 0; i < 4; ++i) { const int row = half * 128 + krow + 32 * i; const u32x4 kv = ka[i];
                float f[8] = {bf_lo(kv.x), bf_hi(kv.x), bf_lo(kv.y), bf_hi(kv.y), bf_lo(kv.z), bf_hi(kv.z), bf_lo(kv.w), bf_hi(kv.w)};
                float ss = 0.f;
#pragma unroll
                for (int e = 0; e < 8; ++e) ss += f[e] * f[e];
                ss += shx(ss, 1); ss += shx(ss, 2); ss += shx(ss, 4); ss += shx(ss, 8);
                const float rk = rsqrtf(ss * (1.0f / 128.0f) + NEPS);
#pragma unroll
                for (int e = 0; e < 4; ++e) { f[e] *= rk * kg0[e]; f[4 + e] *= rk * kg1[e]; }
                *(LAS bf16x8*)(Ks + row * 256 + ((ch ^ (row & 15)) << 4)) = pack8(f);
                *(LAS u32x4*)(Vs + row * 256 + (((ch >> 1) ^ (row & 7)) << 5) + (ch & 1) * 16) = va[i]; } };
        auto load_q = [&](int r_, int n_, u32x4* dst) {
            const size_t qrow_ = rowbase + (size_t)(n_ * 128 + 16 * w + fr) * dil + r_;
            const bf16_t* qp = qkv_c + qrow_ * 18432 + 8 * fq;
#pragma unroll
            for (int ks = 0; ks < 4; ++ks) dst[ks] = *(const u32x4*)(qp + 32 * ks); };
        const int r0 = blk0 >> nbl2, n0 = blk0 & nbm;
        if (tid < 129) { const int bk = t5_bucket(tid * dil); biasL[tid] = P.rel_bias[bk * 48 + g * 16 + h] * LOG2E; }
        if (tid >= 256 && tid < 384) biasL[132 + tid - 256] = P.att_q_gain[g * 128 + tid - 256];
        if (n0 > 0) { load_block(r0, n0 - 1); stage_block((n0 - 1) & 1); }
        else {
#pragma unroll
            for (int i = 0; i < 4; ++i) { const int row = 128 + krow + 32 * i; *(LAS u32x4*)(Ks + row * 256 + ch * 16) = (u32x4){0u, 0u, 0u, 0u}; *(LAS u32x4*)(Vs + row * 256 + ch * 16) = (u32x4){0u, 0u, 0u, 0u}; } }
        load_block(r0, n0); stage_block(n0 & 1);
        load_q(r0, n0, qraw);
        __syncthreads();
#pragma unroll 1
        for (int i4 = 0; i4 < 4; ++i4) {
            const int blk = blk0 + i4, r = blk >> nbl2, n = blk & nbm;
            const int blkn = blk + 1, rn = blkn >> nbl2, nn = blkn & nbm;
            const size_t qrow = rowbase + (size_t)(n * 128 + 16 * w + fr) * dil + r;
            bf16x8 qf[4];
            {
                float ss = 0.f;
#pragma unroll
                for (int ks = 0; ks < 4; ++ks) {
                    const float f[8] = {bf_lo(qraw[ks].x), bf_hi(qraw[ks].x), bf_lo(qraw[ks].y), bf_hi(qraw[ks].y), bf_lo(qraw[ks].z), bf_hi(qraw[ks].z), bf_lo(qraw[ks].w), bf_hi(qraw[ks].w)};
#pragma unroll
                    for (int e = 0; e < 8; ++e) ss += f[e] * f[e]; }
                ss += shx(ss, 16); ss += shx(ss, 32);
                const float rq = rsqrtf(ss * (1.0f / 128.0f) + NEPS) * (0.08838834764831845f * LOG2E);
#pragma unroll
                for (int ks = 0; ks < 4; ++ks) { const LAS float* gp = biasL + 132 + 32 * ks + 8 * fq; const f32x4 g0 = *(const LAS f32x4*)gp, g1 = *(const LAS f32x4*)(gp + 4);
                    float f[8] = {bf_lo(qraw[ks].x), bf_hi(qraw[ks].x), bf_lo(qraw[ks].y), bf_hi(qraw[ks].y), bf_lo(qraw[ks].z), bf_hi(qraw[ks].z), bf_lo(qraw[ks].w), bf_hi(qraw[ks].w)};
#pragma unroll
                    for (int e = 0; e < 4; ++e) { f[e] *= rq * g0[e]; f[4 + e] *= rq * g1[e]; }
                    qf[ks] = pack8(f); }
            }
            if (i4 < 3) { load_block(rn, nn); load_q(rn, nn, qnext); }
            f32x4 sc[9];
            {
                bf16x8 kfa[2][4];
                auto load_kf = [&](int tt, bf16x8* dst) { const int t = w + tt; const int row = (((n + 1 + (t >> 3)) & 1) << 7) + ((t & 7) << 4) + fr;
#pragma unroll
                    for (int ks = 0; ks < 4; ++ks) dst[ks] = *(const LAS bf16x8*)(Ks + row * 256 + (((4 * ks + fq) ^ fr) << 4)); };
                load_kf(0, kfa[0]);
#pragma unroll
                for (int tt = 0; tt < 9; ++tt) {
                    if (tt + 1 < 9) load_kf(tt + 1, kfa[(tt + 1) & 1]);
                    __builtin_amdgcn_sched_barrier(0);
                    f32x4 a = (f32x4){0.f, 0.f, 0.f, 0.f};
#pragma unroll
                    for (int ks = 0; ks < 4; ++ks) a = MFMA16(kfa[tt & 1][ks], qf[ks], a);
                    sc[tt] = a;
                    __builtin_amdgcn_sched_barrier(0);
                }
            }
            float mx = -3.0e38f;
#pragma unroll
            for (int tt = 0; tt < 9; ++tt)
#pragma unroll
                for (int j = 0; j < 4; ++j) { const int delta = 128 + fr - 16 * tt - 4 * fq - j; const int ki = 16 * (w + tt) + 4 * fq + j;
                    const bool valid = (delta >= 0) && (delta <= 128) && (n > 0 || ki >= 128);
                    const int dc = delta < 0 ? 0 : (delta > 128 ? 128 : delta);
                    const float s = valid ? sc[tt][j] + biasL[dc] : -1.0e30f;
                    sc[tt][j] = s; mx = fmaxf(mx, s); }
            mx = fmaxf(mx, shx(mx, 16)); mx = fmaxf(mx, shx(mx, 32));
            float sum = 0.f;
#pragma unroll
            for (int tt = 0; tt < 9; ++tt)
#pragma unroll
                for (int j = 0; j < 4; ++j) { const float p = __builtin_amdgcn_exp2f(sc[tt][j] - mx); sc[tt][j] = p; sum += p; }
            sum += shx(sum, 16); sum += shx(sum, 32);
            f32x4 oacc[8];
#pragma unroll
            for (int dt = 0; dt < 8; ++dt) oacc[dt] = (f32x4){0.f, 0.f, 0.f, 0.f};
            bf16x8 pb[5];
#pragma unroll
            for (int s2 = 0; s2 < 5; ++s2) { float pf[8];
#pragma unroll
                for (int j = 0; j < 4; ++j) { pf[j] = sc[2 * s2][j]; pf[4 + j] = (2 * s2 + 1 <= 8) ? sc[(2 * s2 + 1 <= 8) ? 2 * s2 + 1 : 8][j] : 0.f; }
                pb[s2] = pack8(pf); }
            {
                bf16x8 vfa[2][2];
                auto load_vf = [&](int hb, bf16x8* dst) { const int s2 = hb >> 2, dh = (hb & 3) * 2;
                    const int t0 = w + 2 * s2; int t1 = w + 2 * s2 + 1; t1 = t1 > 15 ? 15 : t1;
                    const int rw0 = (((n + 1 + (t0 >> 3)) & 1) << 7) + ((t0 & 7) << 4), rw1 = (((n + 1 + (t1 >> 3)) & 1) << 7) + ((t1 & 7) << 4);
                    const LAS unsigned char* v0 = Vs + rw0 * 256; const LAS unsigned char* v1 = Vs + rw1 * 256;
#pragma unroll
                    for (int d = 0; d < 2; ++d) dst[d] = tr_frag(v0 + vtr[dh + d], v1 + vtr[dh + d]); };
                load_vf(0, vfa[0]);
#pragma unroll
                for (int hb = 0; hb < 20; ++hb) {
                    if (hb + 1 < 20) load_vf(hb + 1, vfa[(hb + 1) & 1]);
                    __builtin_amdgcn_sched_barrier(0);
#pragma unroll
                    for (int d = 0; d < 2; ++d) oacc[(hb & 3) * 2 + d] = MFMA16(vfa[hb & 1][d], pb[hb >> 2], oacc[(hb & 3) * 2 + d]);
                    __builtin_amdgcn_sched_barrier(0);
                }
            }
            const float inv = 1.0f / sum;
            bf16_t* op = OG + ((size_t)g * 8192 + qrow) * 2048 + h * 128 + 4 * fq;
#pragma unroll
            for (int dt = 0; dt < 8; ++dt) { u32x2 wv; wv.x = cvt_pk_bf16(oacc[dt][0] * inv, oacc[dt][1] * inv); wv.y = cvt_pk_bf16(oacc[dt][2] * inv, oacc[dt][3] * inv); *(u32x2*)(op + 16 * dt) = wv; }
            if (fq == 0) LSE[((size_t)g * 8192 + qrow) * 16 + h] = mx + __log2f(sum);
            ATT_RAW_BAR();
            if (i4 < 3) { stage_block(nn & 1);
#pragma unroll
                for (int ks = 0; ks < 4; ++ks) qraw[ks] = qnext[ks]; }
            ATT_RAW_BAR();
        }
    }
}
DI void merge_phase(const Params& P, int cb) {
    const bf16_t* OG = (const bf16_t*)(P.ws + OFF_OG); const float* LSE = (const float*)(P.ws + OFF_LSE);
    bf16_t* O = (bf16_t*)(P.ws + OFF_O) + (size_t)cb * 8192 * 2048;
    const int tid = tidx();
    const int c8 = (tid & 255) * 8, h = c8 >> 7;
    for (int pr0 = bidx() * 4; pr0 < 4096; pr0 += gridDim.x * 4) {
        float l[4][3]; u32x4 a[4][3];
#pragma unroll
        for (int q = 0; q < 4; ++q) { const int tok = (pr0 + q) * 2 + (tid >> 8);
#pragma unroll
            for (int g = 0; g < 3; ++g) { l[q][g] = LSE[((size_t)g * 8192 + tok) * 16 + h]; a[q][g] = *(const u32x4*)(OG + ((size_t)g * 8192 + tok) * 2048 + c8); } }
#pragma unroll
        for (int q = 0; q < 4; ++q) { const int tok = (pr0 + q) * 2 + (tid >> 8);
            const float m = fmaxf(l[q][0], fmaxf(l[q][1], l[q][2]));
            float w0 = __builtin_amdgcn_exp2f(l[q][0] - m), w1 = __builtin_amdgcn_exp2f(l[q][1] - m), w2 = __builtin_amdgcn_exp2f(l[q][2] - m);
            const float inv = 1.0f / (w0 + w1 + w2); w0 *= inv; w1 *= inv; w2 *= inv;
            const u32x4 x = a[q][0], y = a[q][1], z = a[q][2];
            u32x4 o;
            o.x = cvt_pk_bf16(w0 * bf_lo(x.x) + w1 * bf_lo(y.x) + w2 * bf_lo(z.x), w0 * bf_hi(x.x) + w1 * bf_hi(y.x) + w2 * bf_hi(z.x));
            o.y = cvt_pk_bf16(w0 * bf_lo(x.y) + w1 * bf_lo(y.y) + w2 * bf_lo(z.y), w0 * bf_hi(x.y) + w1 * bf_hi(y.y) + w2 * bf_hi(z.y));
            o.z = cvt_pk_bf16(w0 * bf_lo(x.z) + w1 * bf_lo(y.z) + w2 * bf_lo(z.z), w0 * bf_hi(x.z) + w1 * bf_hi(y.z) + w2 * bf_hi(z.z));
            o.w = cvt_pk_bf16(w0 * bf_lo(x.w) + w1 * bf_lo(y.w) + w2 * bf_lo(z.w), w0 * bf_hi(x.w) + w1 * bf_hi(y.w) + w2 * bf_hi(z.w));
            *(u32x4*)(O + (size_t)tok * 2048 + c8) = o; }
    }
}
DI int swz32(int chunk, int row) { return (((chunk & 15) ^ (row & 15)) | (chunk & 16)) << 4; }
#define RAW_BAR() do { asm volatile("s_waitcnt lgkmcnt(0)" ::: "memory"); __builtin_amdgcn_s_barrier(); asm volatile("" ::: "memory"); } while (0)
DI void scan_phase(const Params& P, LAS unsigned char* L) {
    const bf16_t* RQ = (const bf16_t*)(P.ws + OFF_RQ); const bf16_t* RK = (const bf16_t*)(P.ws + OFF_RK); const bf16_t* RV = (const bf16_t*)(P.ws + OFF_RV);
    bf16_t* RO = (bf16_t*)(P.ws + OFF_RO); float* SSQ = (float*)(P.ws + OFF_SSQ);
    const int tid = tidx(), lane = tid & 63, w = __builtin_amdgcn_readfirstlane(tid >> 6), fr = lane & 15, fq = lane >> 4;
    LAS unsigned char* S = L; LAS unsigned char* Kb = L + 65536; LAS unsigned char* Vs = L + 131072;
    int xb[4], ktr[2], wb[2], vtr[8];
    const int q4 = fr >> 2, p4 = fr & 3;
#pragma unroll
    for (int a = 0; a < 4; ++a) xb[a] = fr * 512 + (((4 * a + fq) ^ fr) << 4);
#pragma unroll
    for (int a = 0; a < 2; ++a) {
        ktr[a] = (4 * fq + q4) * 512 + ((((4 * w + 2 * a + (p4 >> 1)) & 15) ^ (4 * fq + q4)) << 4) + ((w >> 2) << 8) + (p4 & 1) * 8;
        wb[a] = fr * 512 + ((((4 * w + 2 * a + (fq >> 1)) & 15) ^ fr) << 4) + ((w >> 2) << 8) + (fq & 1) * 8; }
#pragma unroll
    for (int vt = 0; vt < 8; ++vt) vtr[vt] = (4 * fq + q4) * 256 + ((vt ^ (4 * (fq & 1) + q4)) << 5) + p4 * 8;
    const int km = lane >> 5, kcp = lane & 31;
    const int vm = lane >> 4, vcp = lane & 15;
    const unsigned kgo = (unsigned)(km * 2048 + ((kcp & 16) | ((kcp & 15) ^ ((2 * w + km) & 15))) * 8);
    const unsigned vgo = (unsigned)(vm * 4096 + ((((vcp >> 1) ^ ((4 * w + vm) & 7)) << 1) | (vcp & 1)) * 8);
    for (int it = bidx(); it < 256; it += gridDim.x) {
        const int vs = it & 3, h = (it >> 2) & 7, b = it >> 5;
        const float l2g = __log2f(1.0f - exp2f(-5.0f - (float)h));
        const float gC = exp2f(128.0f * l2g);
        f32x4 sacc[2][8];
#pragma unroll
        for (int a = 0; a < 2; ++a)
#pragma unroll
            for (int v = 0; v < 8; ++v) sacc[a][v] = (f32x4){0.f, 0.f, 0.f, 0.f};
        __syncthreads();
#pragma unroll
        for (int i = 0; i < 8; ++i) *(LAS u32x4*)(S + (tid + 512 * i) * 16) = (u32x4){0u, 0u, 0u, 0u};
        auto stage_kv = [&](size_t t0) {
#pragma unroll
            for (int i = 0; i < 8; ++i) { const bf16_t* kp = RK + (t0 + 16 * i + 2 * w) * 2048 + h * 256;
                __builtin_amdgcn_global_load_lds((const unsigned*)(kp + kgo), (LAS unsigned*)(Kb + (i * 8 + w) * 1024), 16, 0, 0); }
#pragma unroll
            for (int i = 0; i < 4; ++i) { const bf16_t* vp = RV + (t0 + 32 * i + 4 * w) * 4096 + h * 512 + vs * 128;
                __builtin_amdgcn_global_load_lds((const unsigned*)(vp + vgo), (LAS unsigned*)(Vs + (i * 8 + w) * 1024), 16, 0, 0); } };
        bf16x8 qf[8];
        auto load_q = [&](size_t t0) { const bf16_t* qp = RQ + (t0 + 16 * w) * 2048 + h * 256; const unsigned qo = (unsigned)(fr * 2048 + 8 * fq);
#pragma unroll
            for (int ks = 0; ks < 8; ++ks) qf[ks] = *(const bf16x8*)(qp + (qo + 32 * ks)); };
        load_q((size_t)b * 4096); stage_kv((size_t)b * 4096);
        __syncthreads();
        for (int c = 0; c < 32; ++c) {
            const size_t t0 = (size_t)b * 4096 + c * 128;
            f32x4 oacc[8];
#pragma unroll
            for (int vt = 0; vt < 8; ++vt) { f32x4 a = (f32x4){0.f, 0.f, 0.f, 0.f}; bf16x8 sfa[8];
#pragma unroll
                for (int ks = 0; ks < 8; ++ks) sfa[ks] = *(const LAS bf16x8*)(S + vt * 8192 + xb[ks & 3] + (ks >> 2) * 256);
                __builtin_amdgcn_sched_barrier(0);
#pragma unroll
                for (int ks = 0; ks < 8; ++ks) a = MFMA16(sfa[ks], qf[ks], a);
                oacc[vt] = a; }
            asm volatile("s_waitcnt vmcnt(0)" ::: "memory");
            RAW_BAR();
            unsigned pk[8][2];
#pragma unroll
            for (int mt = 0; mt < 8; ++mt) {
                f32x4 a = (f32x4){0.f, 0.f, 0.f, 0.f};
                if (mt <= w) {
                    bf16x8 kfa[8];
#pragma unroll
                    for (int ks = 0; ks < 8; ++ks) kfa[ks] = *(const LAS bf16x8*)(Kb + mt * 8192 + xb[ks & 3] + (ks >> 2) * 256);
                    __builtin_amdgcn_sched_barrier(0);
#pragma unroll
                    for (int ks = 0; ks < 8; ++ks) a = MFMA16(kfa[ks], qf[ks], a);
#pragma unroll
                    for (int j = 0; j < 4; ++j) a[j] = (mt < w || 4 * fq + j <= fr) ? a[j] : 0.f; }
                pk[mt][0] = cvt_pk_bf16(a[0], a[1]); pk[mt][1] = cvt_pk_bf16(a[2], a[3]); }
            const size_t tn = t0 + (c + 1 < 32 ? 128 : 0);
            load_q(tn);
#pragma unroll
            for (int ms = 0; ms < 4; ++ms) {
                u32x4 pw; pw.x = pk[2 * ms][0]; pw.y = pk[2 * ms][1]; pw.z = pk[2 * ms + 1][0]; pw.w = pk[2 * ms + 1][1];
                const bf16x8 pb = __builtin_bit_cast(bf16x8, pw);
                const LAS unsigned char* k0 = Kb + (32 * ms) * 512; const LAS unsigned char* v0 = Vs + (32 * ms) * 256;
                const bf16x8 kf0 = tr_frag(k0 + ktr[0], k0 + 16 * 512 + ktr[0]), kf1 = tr_frag(k0 + ktr[1], k0 + 16 * 512 + ktr[1]);
#pragma unroll
                for (int vt = 0; vt < 8; ++vt) { const bf16x8 vf = tr_frag(v0 + vtr[vt], v0 + 16 * 256 + vtr[vt]);
                    if (2 * ms <= w) oacc[vt] = MFMA16(vf, pb, oacc[vt]);
                    sacc[0][vt] = MFMA16(kf0, vf, sacc[0][vt]); sacc[1][vt] = MFMA16(kf1, vf, sacc[1][vt]); }
            }
            {
                const float dn = exp2f((float)(16 * w + fr + 1) * l2g);
                bf16_t* op = RO + (t0 + 16 * w) * 4096 + h * 512 + vs * 128 + (unsigned)(fr * 4096 + 4 * fq);
                float ss = 0.f;
#pragma unroll
                for (int vt = 0; vt < 8; ++vt) { const f32x4 o = oacc[vt] * dn; ss += o[0] * o[0] + o[1] * o[1] + o[2] * o[2] + o[3] * o[3];
                    u32x2 wv; wv.x = cvt_pk_bf16(o[0], o[1]); wv.y = cvt_pk_bf16(o[2], o[3]); *(u32x2*)(op + 16 * vt) = wv; }
                ss += shx(ss, 16); ss += shx(ss, 32);
                if (fq == 0) (SSQ + (t0 + 16 * w) * 32 + h * 4 + vs)[(unsigned)(fr * 32)] = ss;
            }
#pragma unroll
            for (int a = 0; a < 2; ++a)
#pragma unroll
                for (int v = 0; v < 8; ++v) sacc[a][v] *= gC;
            RAW_BAR();
#pragma unroll
            for (int ks = 0; ks < 8; ++ks) asm volatile("" :: "v"(qf[ks]));
            stage_kv(tn);
#pragma unroll
            for (int a = 0; a < 2; ++a)
#pragma unroll
                for (int vt = 0; vt < 8; ++vt) {
                    u32x2 wv; wv.x = cvt_pk_bf16(sacc[a][vt][0], sacc[a][vt][1]); wv.y = cvt_pk_bf16(sacc[a][vt][2], sacc[a][vt][3]);
                    *(LAS u32x2*)(S + vt * 8192 + wb[a]) = wv; }
            RAW_BAR();
        }
    }
}

constexpr int NPH = 23;
constexpr int MAXPH = NPH;
DI void decode_phase(int ph, int& type, int& a0, int& a1, int& a2) {
    a0 = 0; a1 = 0; a2 = -1;
    if (ph == 0) type = 0;
    else if (ph == 1) { type = 1; }
    else if (ph < 10) { const int q = (ph - 2) >> 1; a0 = q; if ((ph - 2) & 1) type = 3; else { type = 2; a1 = q > 0 ? 1 : 0; } }
    else if (ph == 10) { type = 4; a0 = 3; }
    else if (ph == 11) { type = 5; a0 = 0; }
    else if (ph == 12) { type = 1; a0 = 0; a1 = 1; }
    else if (ph == 13) { type = 6; a0 = 0; }
    else if (ph == 14) { type = 5; a0 = 1; }
    else if (ph == 15) { type = 1; a0 = 1; a1 = 0; a2 = 1; }
    else if (ph == 16) type = 7;
    else if (ph == 17) type = 8;
    else if (ph == 18) type = 9;
    else if (ph == 19) { type = 5; a0 = 2; }
    else if (ph == 20) { type = 1; a0 = 1; a1 = 1; a2 = 2; }
    else if (ph == 21) { type = 6; a0 = 1; }
    else { type = 5; a0 = 3; }
}
template <int TYPE> DI void run_phase(const Params& P, int a0, int a1, int a2, LAS unsigned char* L) {
    unsigned char* ws = P.ws; const float* mod = (const float*)(ws + OFF_MOD);
    pg8::StaticOrder S;
    if constexpr (TYPE == 0) { mod_gemv(P, (LAS float*)L); rotary_tables(P); __syncthreads(); convert_set(P, 0, (LAS unsigned*)L); }
    else if constexpr (TYPE == 1) { if (a2 >= 0) convert_set(P, a2, (LAS unsigned*)L); norm_phase(P, a0, a1); }
    else if constexpr (TYPE == 2) { if (a1) merge_phase(P, a0 - 1);
        pg8::Gemm g{(const bf16_t*)(ws + OFF_H) + (size_t)a0 * 8192 * 2048, (const bf16_t*)(ws + OFF_WQKV0), 8192, 18432, 2048};
        S.init(g.M, g.N, gridDim.x, bidx(), 4); EpiPlainBf16 E{(bf16_t*)(ws + OFF_QKVC), 18432};
        pg8::gemm_phase<EpiPlainBf16, pg8::StaticOrder>(L, g, S, E); }
    else if constexpr (TYPE == 3) attn_phase(P, L);
    else if constexpr (TYPE == 4) merge_phase(P, a0);
    else if constexpr (TYPE == 5) {
        const size_t offA = a0 == 0 ? OFF_O : (a0 == 1 ? OFF_HID0 : (a0 == 2 ? OFF_RO : OFF_HID1));
        const size_t offB = a0 == 0 ? OFF_WO0 : (a0 == 1 ? OFF_WDN0 : (a0 == 2 ? OFF_WRO : OFF_WDN1));
        const int kk = a0 == 0 ? 2048 : (a0 == 2 ? 4096 : DFF);
        const int goff = ((a0 >= 2) ? 8 * MODW : 0) + ((a0 & 1) ? 5 * DM : 2 * DM);
        const float* rsd = a0 == 0 ? P.x : P.out;
        pg8::Gemm g{(const bf16_t*)(ws + offA), (const bf16_t*)(ws + offB), TTOK, DM, kk};
        EpiResid E{rsd, P.out, mod + goff};
        S.init(g.M, g.N, gridDim.x, bidx(), 4);
        pg8::gemm_phase<EpiResid, pg8::StaticOrder>(L, g, S, E); }
    else if constexpr (TYPE == 6) { pg8::Gemm g{(const bf16_t*)(ws + OFF_H), (const bf16_t*)(ws + (a0 ? OFF_WUP1 : OFF_WUP0)), TTOK, 2 * DFF, 2048};
        S.init(g.M, g.N, gridDim.x, bidx()); EpiSwiGLU E{(bf16_t*)(ws + (a0 ? OFF_HID1 : OFF_HID0))};
        pg8::gemm_phase<EpiSwiGLU, pg8::StaticOrder>(L, g, S, E); }
    else if constexpr (TYPE == 7) { pg8::Gemm g{(const bf16_t*)(ws + OFF_H), (const bf16_t*)(ws + OFF_WRQKV), TTOK, 8192, 2048};
        S.init(g.M, g.N, gridDim.x, bidx());
        EpiRetQKV E{(bf16_t*)(ws + OFF_RQ), (bf16_t*)(ws + OFF_RK), (bf16_t*)(ws + OFF_RV), (const float*)(ws + OFF_COS), (const float*)(ws + OFF_SIN)};
        pg8::gemm_phase<EpiRetQKV, pg8::StaticOrder>(L, g, S, E); }
    else if constexpr (TYPE == 8) scan_phase(P, L);
    else { pg8::Gemm g{(const bf16_t*)(ws + OFF_H), (const bf16_t*)(ws + OFF_WRG), TTOK, 4096, 2048};
        S.init(g.M, g.N, gridDim.x, bidx()); EpiRetGate E{(bf16_t*)(ws + OFF_RO), (const float*)(ws + OFF_SSQ)};
        pg8::gemm_phase<EpiRetGate, pg8::StaticOrder>(L, g, S, E); }
}
#ifndef ONE_LAUNCH
#define ONE_LAUNCH 1
#endif
#if ONE_LAUNCH
DI void grid_barrier(unsigned* ctr, unsigned target) {
    asm volatile("s_waitcnt vmcnt(0)" ::: "memory");
    __syncthreads();
    if (threadIdx.x == 0) {
        __builtin_amdgcn_fence(__ATOMIC_RELEASE, "agent");
        asm volatile("s_waitcnt vmcnt(0)" ::: "memory");
        __hip_atomic_fetch_add(ctr, 1u, __ATOMIC_RELAXED, __HIP_MEMORY_SCOPE_AGENT);
        while (__hip_atomic_load(ctr, __ATOMIC_RELAXED, __HIP_MEMORY_SCOPE_AGENT) < target) __builtin_amdgcn_s_sleep(1);
        __builtin_amdgcn_fence(__ATOMIC_ACQUIRE, "agent");
        asm volatile("s_waitcnt vmcnt(0)" ::: "memory");
    }
    __syncthreads();
}
__global__ void __launch_bounds__(NTHREADS, 2) mega_fwd(Params Pin, int ph_lo, int ph_hi) {
    extern __shared__ __attribute__((aligned(16))) unsigned char shm[];
    LAS unsigned char* L = (LAS unsigned char*)shm;
    cg::grid_group grid = cg::this_grid();
    unsigned nbar = 0;
    for (int ph = ph_lo; ph < ph_hi; ++ph) {
        typedef const Params __attribute__((address_space(4))) * KP;
        KP pk = (KP)__builtin_amdgcn_kernarg_segment_ptr();
        asm volatile("" : "+s"(pk));
        Params P;
        P.x = pk->x; P.c = pk->c; P.w_mod = pk->w_mod; P.b_mod = pk->b_mod; P.norm_mix = pk->norm_mix; P.norm_ffn = pk->norm_ffn; P.rel_bias = pk->rel_bias;
        P.att_w_qkv = pk->att_w_qkv; P.att_q_gain = pk->att_q_gain; P.att_k_gain = pk->att_k_gain; P.att_w_o = pk->att_w_o; P.ret_w_qkvg = pk->ret_w_qkvg; P.ret_w_o = pk->ret_w_o;
        P.ffn_w_up = pk->ffn_w_up; P.ffn_w_down = pk->ffn_w_down; P.out = pk->out; P.ws = pk->ws;
        int type, a0, a1, a2; decode_phase(ph, type, a0, a1, a2);
        switch (type) {
            case 0: run_phase<0>(P, a0, a1, a2, L); break; case 1: run_phase<1>(P, a0, a1, a2, L); break;
            case 2: run_phase<2>(P, a0, a1, a2, L); break; case 3: run_phase<3>(P, a0, a1, a2, L); break;
            case 4: run_phase<4>(P, a0, a1, a2, L); break; case 5: run_phase<5>(P, a0, a1, a2, L); break;
            case 6: run_phase<6>(P, a0, a1, a2, L); break; case 7: run_phase<7>(P, a0, a1, a2, L); break;
            case 8: run_phase<8>(P, a0, a1, a2, L); break; default: run_phase<9>(P, a0, a1, a2, L); break;
        }
        if (ph + 1 < ph_hi) {
            unsigned* ctr = (unsigned*)(P.ws + OFF_BAR);
            if (ph == ph_lo) { if (blockIdx.x == 0 && threadIdx.x == 0) __hip_atomic_store(ctr, 0u, __ATOMIC_RELAXED, __HIP_MEMORY_SCOPE_AGENT); grid.sync(); }
            else { ++nbar; grid_barrier(ctr, nbar * gridDim.x); }
        }
    }
}
#endif
extern "C" void kernel_launch(void* const* d_in, const int* in_sizes, int n_in, void* d_out, int out_size, void* d_ws, size_t ws_size, hipStream_t stream) {
    static int grid = 0;
    if (grid == 0) {
        int dev = 0, cus = 0;
        (void)hipGetDevice(&dev);
        (void)hipDeviceGetAttribute(&cus, hipDeviceAttributeMultiprocessorCount, dev);
        grid = cus > 0 ? cus : 256;
        if (ws_size < WS_NEED) fprintf(stderr, "kernel_launch: workspace too small: %zu < %zu\n", ws_size, (size_t)WS_NEED);
    }
    Params p{};
    p.x = (const float*)d_in[0]; p.c = (const float*)d_in[1]; p.w_mod = (const float*)d_in[2]; p.b_mod = (const float*)d_in[3]; p.norm_mix = (const float*)d_in[4]; p.norm_ffn = (const float*)d_in[5];
    p.rel_bias = (const float*)d_in[6]; p.att_w_qkv = (const float*)d_in[7]; p.att_q_gain = (const float*)d_in[8]; p.att_k_gain = (const float*)d_in[9]; p.att_w_o = (const float*)d_in[10];
    p.ret_w_qkvg = (const float*)d_in[11]; p.ret_w_o = (const float*)d_in[12]; p.ffn_w_up = (const float*)d_in[13]; p.ffn_w_down = (const float*)d_in[14];
    p.out = (float*)d_out; p.ws = (unsigned char*)d_ws;
#if ONE_LAUNCH
    static bool attr = false;
    if (!attr) { (void)hipFuncSetAttribute((const void*)mega_fwd, hipFuncAttributeMaxDynamicSharedMemorySize, LDS_BYTES); attr = true; }
    int lo = 0, hi = NPH;
    void* args[] = {&p, &lo, &hi};
    hipError_t e = hipLaunchCooperativeKernel((const void*)mega_fwd, dim3(grid), dim3(NTHREADS), args, LDS_BYTES, stream);
    if (e != hipSuccess) fprintf(stderr, "kernel_launch: cooperative launch failed: %s (grid %d)\n", hipGetErrorString(e), grid);
#endif
}
```

```cpp
#include <hip/hip_runtime.h>
#include <hip/hip_cooperative_groups.h>
#include <cstdio>
namespace cg = cooperative_groups;

#define LAS __attribute__((address_space(3)))
#define PG8_LAS LAS
typedef unsigned short bf16_t;
typedef short bf16x8 __attribute__((ext_vector_type(8)));
typedef float f32x4 __attribute__((ext_vector_type(4)));
typedef unsigned u32x4 __attribute__((ext_vector_type(4)));
typedef unsigned u32x2 __attribute__((ext_vector_type(2)));
#define DI __device__ __forceinline__

constexpr int TTOK = 32768, DM = 2048, SEQL = 4096, DFF = 5632, MODW = 12288;
constexpr float LOG2E = 1.4426950408889634f;
constexpr float NEPS = 1e-6f;
constexpr int LDS_BYTES = 163840;
constexpr int NTHREADS = 512;

constexpr size_t MB = 1048576;
constexpr size_t OFF_MOD = 0;
constexpr size_t OFF_COS = 1 * MB;
constexpr size_t OFF_SIN = 3 * MB;
constexpr size_t OFF_LSE = 5 * MB;
constexpr size_t OFF_SSQ = 8 * MB;
constexpr size_t OFF_BAR = 12 * MB;
constexpr size_t OFF_H   = 16 * MB;
constexpr size_t OFF_W   = 144 * MB;
constexpr size_t OFF_WQKV0 = OFF_W;
constexpr size_t OFF_WO0   = OFF_WQKV0 + 72 * MB;
constexpr size_t OFF_WUP0  = OFF_WO0 + 8 * MB;
constexpr size_t OFF_WDN0  = OFF_WUP0 + 44 * MB;
constexpr size_t OFF_BIG0  = OFF_WDN0 + 22 * MB;
constexpr size_t OFF_QKVC  = OFF_BIG0;
constexpr size_t OFF_OG    = OFF_QKVC + 288 * MB;
constexpr size_t OFF_O     = OFF_OG + 96 * MB;
constexpr size_t OFF_HID0  = OFF_BIG0;
constexpr size_t OFF_XB1   = 802 * MB;
constexpr size_t OFF_WRQKV = OFF_W;
constexpr size_t OFF_WRG   = OFF_WRQKV + 32 * MB;
constexpr size_t OFF_WRO   = OFF_WRG + 16 * MB;
constexpr size_t OFF_BIG1  = OFF_WRO + 16 * MB;
constexpr size_t OFF_RQ    = OFF_BIG1;
constexpr size_t OFF_RK    = OFF_RQ + 128 * MB;
constexpr size_t OFF_RV    = OFF_RK + 128 * MB;
constexpr size_t OFF_RO    = OFF_RV + 256 * MB;
constexpr size_t OFF_WUP1  = OFF_BIG1;
constexpr size_t OFF_WDN1  = OFF_WUP1 + 44 * MB;
constexpr size_t OFF_XB3   = 464 * MB;
constexpr size_t OFF_HID1  = 592 * MB;
constexpr size_t WS_NEED   = OFF_RO + 256 * MB;

struct Params {
    const float *x, *c, *w_mod, *b_mod, *norm_mix, *norm_ffn, *rel_bias, *att_w_qkv, *att_q_gain, *att_k_gain, *att_w_o, *ret_w_qkvg, *ret_w_o, *ffn_w_up, *ffn_w_down;
    float* out; unsigned char* ws;
};

DI unsigned cvt_pk_bf16(float lo, float hi) { unsigned r; asm volatile("v_cvt_pk_bf16_f32 %0, %1, %2" : "=v"(r) : "v"(lo), "v"(hi)); return r; }
DI float bf_lo(unsigned u) { return __uint_as_float(u << 16); }
DI float bf_hi(unsigned u) { return __uint_as_float(u & 0xffff0000u); }
DI float silu_f(float v) { return v * __builtin_amdgcn_rcpf(1.0f + __expf(-v)); }
DI float shx(float v, int m) { return __shfl_xor(v, m); }
DI int tidx() { int t = threadIdx.x; asm volatile("" : "+v"(t)); return t; }
DI int bidx() { int b = blockIdx.x; asm volatile("" : "+s"(b)); return b; }

namespace pg8 {
constexpr int BM = 256, BK = 64, HALF = 128, HTB = HALF * BK * 2, STAGE_BYTES = 8 * HTB, NXCD = 8, WGM = 8;
__host__ __device__ __forceinline__ int lds_byte(int r, int c) { const int st = (r >> 4) * 2 + (c >> 5), rr = r & 15, cc = c & 31, ob = rr * 64 + cc * 2; return st * 1024 + (ob ^ (((ob >> 9) & 1) << 5)); }
__host__ __device__ __forceinline__ void stage_rc(int b, int& R, int& C) { const int st = b / 1024, sb = b % 1024, swz = sb ^ (((sb >> 9) & 1) << 5); R = (st >> 1) * 16 + swz / 64; C = (st & 1) * 32 + (swz % 64) / 2; }
__host__ __device__ __forceinline__ int perm32(int rho) { const int n = rho >> 4, i = rho & 15; return 8 * (i >> 2) + 4 * n + (i & 3); }
struct Unit { int pm, pn; };
struct Gemm { const bf16_t* A; const bf16_t* Bt; int M, N, K; };
struct StaticOrder {
    int nM, nN, nwg, G, c, wgm;
    __device__ void init(int M, int N, int G_, int c_, int wgm_ = WGM) { nM = M / BM; nN = N / BM; nwg = nM * nN; G = G_; c = c_; wgm = wgm_; }
    __device__ bool next(int i, Unit& u) const {
        const long L = (long)i * G + c; if (L >= nwg) return false;
        int wgid = (int)L; { const int q = nwg / NXCD, r = nwg % NXCD, xcd = wgid % NXCD, off = wgid / NXCD; wgid = (xcd < r ? xcd * (q + 1) : r * (q + 1) + (xcd - r) * q) + off; }
        const int nig = wgm * nN, gid = wgid / nig, fm = gid * wgm, gsz = (nM - fm) < wgm ? (nM - fm) : wgm;
        u.pm = fm + ((wgid % nig) % gsz); u.pn = (wgid % nig) / gsz; return true;
    }
    __device__ __forceinline__ void a_ready(const Unit&) const {}
    __device__ __forceinline__ void done(const Unit&) const {}
};
template <class Epi, class Sched>
__device__ __forceinline__ void gemm_phase(PG8_LAS unsigned char* lds, const Gemm g, const Sched& S, const Epi& E) {
    const int tid = tidx(), wid = __builtin_amdgcn_readfirstlane(tid >> 6), lane = tid & 63, wr = wid >> 2, wc = wid & 3, fr = lane & 15, fq = lane >> 4;
    const int K = g.K, nt = K / BK;
    unsigned voffA[2], voffB[2];
#pragma unroll
    for (int i = 0; i < 2; ++i) { int R, C; stage_rc(tid * 16 + i * 8192, R, C); const int Rb = Epi::PERM ? ((R & ~31) + perm32(R & 31)) : R;
        voffA[i] = (unsigned)(R * K + C) * 2u; voffB[i] = (unsigned)(Rb * K + C) * 2u; }
    const size_t kstep = (size_t)(BK * 2);
    const size_t hstep = (size_t)HALF * K * 2;
    const size_t tstep = 2 * hstep;
    const unsigned ldsw = (unsigned)wid * 1024u;
    const int aoff = lds_byte(wr * 64 + fr, fq * 8), boff = lds_byte(wc * 32 + fr, fq * 8);
#define PG8_SA(b, h) (((b) * 2 + (h)) * HTB)
#define PG8_SB(b, h) ((4 + (b) * 2 + (h)) * HTB)
#define PG8_STAGE(bufoff, gbase, voff) do { _Pragma("unroll") for (int _i = 0; _i < 2; ++_i) \
        __builtin_amdgcn_global_load_lds((const unsigned*)((const char*)(gbase) + (voff)[_i]), (PG8_LAS unsigned*)(lds + (bufoff) + ldsw + _i * 8192), 16, 0, 0); } while (0)
#define PG8_LDA(dst, b, h) do { _Pragma("unroll") for (int m = 0; m < 4; ++m) _Pragma("unroll") for (int k = 0; k < 2; ++k) dst[m][k] = *(const PG8_LAS bf16x8*)(lds + PG8_SA(b, h) + aoff + m * 2048 + k * 1024); } while (0)
#define PG8_LDB(dst, b, h) do { _Pragma("unroll") for (int n = 0; n < 2; ++n) _Pragma("unroll") for (int k = 0; k < 2; ++k) dst[n][k] = *(const PG8_LAS bf16x8*)(lds + PG8_SB(b, h) + boff + n * 2048 + k * 1024); } while (0)
#define PG8_MMA(ai, bj, At, Bt) do { __builtin_amdgcn_s_setprio(1); _Pragma("unroll") for (int m = 0; m < 4; ++m) _Pragma("unroll") for (int n = 0; n < 2; ++n) _Pragma("unroll") for (int k = 0; k < 2; ++k) \
        acc[ai][bj][m][n] = __builtin_amdgcn_mfma_f32_16x16x32_bf16(Bt[n][k], At[m][k], acc[ai][bj][m][n], 0, 0, 0); __builtin_amdgcn_s_setprio(0); } while (0)
#define PG8_WAIT_V(n) asm volatile("s_waitcnt vmcnt(" #n ")" ::: "memory")
#define PG8_WAIT_L(n) asm volatile("s_waitcnt lgkmcnt(" #n ")" ::: "memory")
#define PG8_BAR __builtin_amdgcn_s_barrier()
#define PG8_SCHED __builtin_amdgcn_sched_barrier(0)
    Unit cur, nxt; int ui = 0;
    if (!S.next(0, cur)) return;
    f32x4 acc[2][2][4][2];
#pragma unroll
    for (int a = 0; a < 2; ++a)
#pragma unroll
        for (int b = 0; b < 2; ++b)
#pragma unroll
            for (int m = 0; m < 4; ++m)
#pragma unroll
                for (int n = 0; n < 2; ++n) acc[a][b][m][n] = (f32x4){0.f, 0.f, 0.f, 0.f};
    bf16x8 At[4][2], B0[2][2], B1[2][2];
    const char* cA = (const char*)g.A + (size_t)cur.pm * tstep; const char* cB = (const char*)g.Bt + (size_t)cur.pn * tstep;
    S.a_ready(cur);
    PG8_STAGE(PG8_SB(0, 0), cB, voffB); PG8_STAGE(PG8_SA(0, 0), cA, voffA); PG8_STAGE(PG8_SB(0, 1), cB + hstep, voffB); PG8_STAGE(PG8_SA(0, 1), cA + hstep, voffA);
    if (wr == 1) PG8_BAR;
    PG8_WAIT_V(4); PG8_BAR;
    PG8_STAGE(PG8_SB(1, 0), cB + kstep, voffB); PG8_STAGE(PG8_SA(1, 0), cA + kstep, voffA); PG8_STAGE(PG8_SB(1, 1), cB + hstep + kstep, voffB);
    PG8_WAIT_V(6); PG8_BAR;
    for (;;) {
        const bool has_next = S.next(ui + 1, nxt);
        const char* nA = has_next ? (const char*)g.A + (size_t)nxt.pm * tstep : cA; const char* nB = has_next ? (const char*)g.Bt + (size_t)nxt.pn * tstep : cB;
        for (int t = 0; t < nt; t += 2) {
            const bool last = (t == nt - 2);
            const char* a1 = cA + (size_t)(t + 1) * kstep;
            const char* a2 = last ? nA : cA + (size_t)(t + 2) * kstep; const char* b2 = last ? nB : cB + (size_t)(t + 2) * kstep;
            const char* a3 = a2 + kstep; const char* b3 = b2 + kstep;
            if (last && has_next) S.a_ready(nxt);
            PG8_LDB(B0, 0, 0); PG8_SCHED; PG8_LDA(At, 0, 0); PG8_STAGE(PG8_SA(1, 1), a1 + hstep, voffA);
            PG8_WAIT_L(8); PG8_BAR; PG8_WAIT_L(0); PG8_MMA(0, 0, At, B0); PG8_BAR; PG8_SCHED;
            PG8_LDB(B1, 0, 1); PG8_STAGE(PG8_SB(0, 0), b2, voffB);
            PG8_BAR; PG8_WAIT_L(0); PG8_MMA(0, 1, At, B1); PG8_BAR;
            PG8_LDA(At, 0, 1); PG8_STAGE(PG8_SA(0, 0), a2, voffA);
            PG8_BAR; PG8_WAIT_L(0); PG8_MMA(1, 0, At, B0); PG8_BAR; PG8_SCHED;
            PG8_STAGE(PG8_SB(0, 1), b2 + hstep, voffB);
            PG8_WAIT_V(6); PG8_BAR; PG8_MMA(1, 1, At, B1); PG8_BAR;
            PG8_LDB(B0, 1, 0); PG8_SCHED; PG8_LDA(At, 1, 0); PG8_STAGE(PG8_SA(0, 1), a2 + hstep, voffA);
            PG8_WAIT_L(8); PG8_BAR; PG8_WAIT_L(0); PG8_MMA(0, 0, At, B0); PG8_BAR; PG8_SCHED;
            PG8_LDB(B1, 1, 1); PG8_STAGE(PG8_SB(1, 0), b3, voffB);
            PG8_BAR; PG8_WAIT_L(0); PG8_MMA(0, 1, At, B1); PG8_BAR;
            PG8_LDA(At, 1, 1); PG8_STAGE(PG8_SA(1, 0), a3, voffA);
            PG8_BAR; PG8_WAIT_L(0); PG8_MMA(1, 0, At, B0); PG8_BAR; PG8_SCHED;
            PG8_STAGE(PG8_SB(1, 1), b3 + hstep, voffB);
            PG8_WAIT_V(6); PG8_BAR; PG8_MMA(1, 1, At, B1); PG8_BAR;
        }
        E(acc, cur, wr, wc, fr, fq); S.done(cur);
        if (!has_next) break;
#pragma unroll
        for (int a = 0; a < 2; ++a)
#pragma unroll
            for (int b = 0; b < 2; ++b)
#pragma unroll
                for (int m = 0; m < 4; ++m)
#pragma unroll
                    for (int n = 0; n < 2; ++n) acc[a][b][m][n] = (f32x4){0.f, 0.f, 0.f, 0.f};
        cur = nxt; cA = nA; cB = nB; ++ui;
    }
    PG8_WAIT_V(0);
    if (wr == 0) PG8_BAR;
    PG8_BAR;
#undef PG8_SA
#undef PG8_SB
#undef PG8_STAGE
#undef PG8_LDA
#undef PG8_LDB
#undef PG8_MMA
#undef PG8_WAIT_V
#undef PG8_WAIT_L
#undef PG8_BAR
#undef PG8_SCHED
}
}
using pg8::Unit;
typedef f32x4 AccT[2][2][4][2];

struct EpiPlainBf16 {
    static constexpr bool PERM = true;
    bf16_t* O; int ldc;
    DI void operator()(const AccT& acc, const Unit& u, int wr, int wc, int fr, int fq) const {
        const int row0 = u.pm * 256 + wr * 64 + fr, col0 = u.pn * 256 + wc * 32 + 8 * fq;
#pragma unroll
        for (int ai = 0; ai < 2; ++ai)
#pragma unroll
            for (int m = 0; m < 4; ++m) { bf16_t* rowp = O + (size_t)(row0 + ai * 128 + m * 16) * ldc + col0;
#pragma unroll
                for (int bj = 0; bj < 2; ++bj) { const f32x4 v0 = acc[ai][bj][m][0], v1 = acc[ai][bj][m][1];
                    u32x4 w; w.x = cvt_pk_bf16(v0[0], v0[1]); w.y = cvt_pk_bf16(v0[2], v0[3]); w.z = cvt_pk_bf16(v1[0], v1[1]); w.w = cvt_pk_bf16(v1[2], v1[3]);
                    *(u32x4*)(rowp + bj * 128) = w; } }
    }
};
struct EpiResid {
    static constexpr bool PERM = false;
    const float* R; float* O; const float* gate;
    DI void operator()(const AccT& acc, const Unit& u, int wr, int wc, int fr, int fq) const {
        const int row0 = u.pm * 256 + wr * 64 + fr, col0 = u.pn * 256 + wc * 32 + 4 * fq;
        const int b = (u.pm * 256) >> 12;
        f32x4 gv[2][2];
#pragma unroll
        for (int bj = 0; bj < 2; ++bj)
#pragma unroll
            for (int n = 0; n < 2; ++n) gv[bj][n] = *(const f32x4*)(gate + (size_t)b * MODW + col0 + bj * 128 + n * 16);
#pragma unroll
        for (int ai = 0; ai < 2; ++ai)
#pragma unroll
            for (int mp = 0; mp < 2; ++mp) {
                f32x4 rv[2][2][2];
#pragma unroll
                for (int mm = 0; mm < 2; ++mm) { const size_t ro = (size_t)(row0 + ai * 128 + (2 * mp + mm) * 16) * DM + col0;
#pragma unroll
                    for (int bj = 0; bj < 2; ++bj)
#pragma unroll
                        for (int n = 0; n < 2; ++n) rv[mm][bj][n] = *(const f32x4*)(R + ro + bj * 128 + n * 16); }
#pragma unroll
                for (int mm = 0; mm < 2; ++mm) { const size_t ro = (size_t)(row0 + ai * 128 + (2 * mp + mm) * 16) * DM + col0;
#pragma unroll
                    for (int bj = 0; bj < 2; ++bj)
#pragma unroll
                        for (int n = 0; n < 2; ++n) *(f32x4*)(O + ro + bj * 128 + n * 16) = rv[mm][bj][n] + gv[bj][n] * acc[ai][bj][2 * mp + mm][n]; }
            }
    }
};
struct EpiResidF2B {
    static constexpr bool PERM = true;
    const float* R; bf16_t* O; const float* gate;
    DI void operator()(const AccT& acc, const Unit& u, int wr, int wc, int fr, int fq) const {
        const int row0 = u.pm * 256 + wr * 64 + fr, col0 = u.pn * 256 + wc * 32 + 8 * fq;
        const int b = (u.pm * 256) >> 12;
        f32x4 gv[2][2];
#pragma unroll
        for (int bj = 0; bj < 2; ++bj)
#pragma unroll
            for (int n = 0; n < 2; ++n) gv[bj][n] = *(const f32x4*)(gate + (size_t)b * MODW + col0 + bj * 128 + n * 4);
#pragma unroll
        for (int ai = 0; ai < 2; ++ai)
#pragma unroll
            for (int mp = 0; mp < 2; ++mp) {
                f32x4 rv[2][2][2];
#pragma unroll
                for (int mm = 0; mm < 2; ++mm) { const size_t ro = (size_t)(row0 + ai * 128 + (2 * mp + mm) * 16) * DM + col0;
#pragma unroll
                    for (int bj = 0; bj < 2; ++bj)
#pragma unroll
                        for (int n = 0; n < 2; ++n) rv[mm][bj][n] = *(const f32x4*)(R + ro + bj * 128 + n * 4); }
#pragma unroll
                for (int mm = 0; mm < 2; ++mm) { const size_t ro = (size_t)(row0 + ai * 128 + (2 * mp + mm) * 16) * DM + col0;
#pragma unroll
                    for (int bj = 0; bj < 2; ++bj) { const f32x4 v0 = rv[mm][bj][0] + gv[bj][0] * acc[ai][bj][2 * mp + mm][0], v1 = rv[mm][bj][1] + gv[bj][1] * acc[ai][bj][2 * mp + mm][1];
                        u32x4 w; w.x = cvt_pk_bf16(v0[0], v0[1]); w.y = cvt_pk_bf16(v0[2], v0[3]); w.z = cvt_pk_bf16(v1[0], v1[1]); w.w = cvt_pk_bf16(v1[2], v1[3]);
                        *(u32x4*)(O + ro + bj * 128) = w; } }
            }
    }
};
struct EpiResidB2F {
    static constexpr bool PERM = true;
    const bf16_t* R; float* O; const float* gate;
    DI void operator()(const AccT& acc, const Unit& u, int wr, int wc, int fr, int fq) const {
        const int row0 = u.pm * 256 + wr * 64 + fr, col0 = u.pn * 256 + wc * 32 + 8 * fq;
        const int b = (u.pm * 256) >> 12;
        f32x4 gv[2][2];
#pragma unroll
        for (int bj = 0; bj < 2; ++bj)
#pragma unroll
            for (int n = 0; n < 2; ++n) gv[bj][n] = *(const f32x4*)(gate + (size_t)b * MODW + col0 + bj * 128 + n * 4);
#pragma unroll
        for (int ai = 0; ai < 2; ++ai) {
            u32x4 rb[4][2];
#pragma unroll
            for (int m = 0; m < 4; ++m) { const size_t ro = (size_t)(row0 + ai * 128 + m * 16) * DM + col0;
#pragma unroll
                for (int bj = 0; bj < 2; ++bj) rb[m][bj] = *(const u32x4*)(R + ro + bj * 128); }
#pragma unroll
            for (int m = 0; m < 4; ++m) { const size_t ro = (size_t)(row0 + ai * 128 + m * 16) * DM + col0;
#pragma unroll
                for (int bj = 0; bj < 2; ++bj) { const u32x4 t = rb[m][bj];
                    const f32x4 r0 = (f32x4){bf_lo(t.x), bf_hi(t.x), bf_lo(t.y), bf_hi(t.y)}, r1 = (f32x4){bf_lo(t.z), bf_hi(t.z), bf_lo(t.w), bf_hi(t.w)};
                    *(f32x4*)(O + ro + bj * 128) = r0 + gv[bj][0] * acc[ai][bj][m][0];
                    *(f32x4*)(O + ro + bj * 128 + 4) = r1 + gv[bj][1] * acc[ai][bj][m][1]; } }
        }
    }
};
struct EpiSwiGLU {
    static constexpr bool PERM = true;
    bf16_t* O;
    DI void operator()(const AccT& acc, const Unit& u, int wr, int wc, int fr, int fq) const {
        const int row0 = u.pm * 256 + wr * 64 + fr, col0 = u.pn * 128 + wc * 32 + 8 * fq;
#pragma unroll
        for (int ai = 0; ai < 2; ++ai)
#pragma unroll
            for (int m = 0; m < 4; ++m) { bf16_t* rowp = O + (size_t)(row0 + ai * 128 + m * 16) * DFF + col0;
                float r[8];
#pragma unroll
                for (int n = 0; n < 2; ++n)
#pragma unroll
                    for (int e = 0; e < 4; ++e) r[n * 4 + e] = silu_f(acc[ai][0][m][n][e]) * acc[ai][1][m][n][e];
                u32x4 w; w.x = cvt_pk_bf16(r[0], r[1]); w.y = cvt_pk_bf16(r[2], r[3]); w.z = cvt_pk_bf16(r[4], r[5]); w.w = cvt_pk_bf16(r[6], r[7]);
                *(u32x4*)rowp = w; }
    }
};
struct EpiRetQKV {
    static constexpr bool PERM = true;
    bf16_t *Q, *Kt, *V; const float *cosT, *sinT;
    DI void operator()(const AccT& acc, const Unit& u, int wr, int wc, int fr, int fq) const {
        const int row0 = u.pm * 256 + wr * 64 + fr, i0 = wc * 32 + 8 * fq;
        if (u.pn >= 16) {
#pragma unroll
            for (int ai = 0; ai < 2; ++ai)
#pragma unroll
                for (int m = 0; m < 4; ++m) { bf16_t* rowp = V + (size_t)(row0 + ai * 128 + m * 16) * 4096 + (u.pn - 16) * 256 + i0;
#pragma unroll
                    for (int bj = 0; bj < 2; ++bj) { const f32x4 v0 = acc[ai][bj][m][0], v1 = acc[ai][bj][m][1];
                        u32x4 w; w.x = cvt_pk_bf16(v0[0], v0[1]); w.y = cvt_pk_bf16(v0[2], v0[3]); w.z = cvt_pk_bf16(v1[0], v1[1]); w.w = cvt_pk_bf16(v1[2], v1[3]);
                        *(u32x4*)(rowp + bj * 128) = w; } }
            return;
        }
        const bool isk = u.pn >= 8; const int hd = u.pn & 7;
        bf16_t* dst = (isk ? Kt : Q) + hd * 256 + i0;
        const float l2g = __log2f(1.0f - exp2f(-5.0f - (float)hd));
#pragma unroll
        for (int ai = 0; ai < 2; ++ai) {
            f32x4 cvs[4][2], svs[4][2];
#pragma unroll
            for (int m = 0; m < 4; ++m) { const int s = (row0 + ai * 128 + m * 16) & 4095;
#pragma unroll
                for (int n = 0; n < 2; ++n) { cvs[m][n] = *(const f32x4*)(cosT + s * 128 + i0 + n * 4); svs[m][n] = *(const f32x4*)(sinT + s * 128 + i0 + n * 4); } }
#pragma unroll
            for (int m = 0; m < 4; ++m) { const int row = row0 + ai * 128 + m * 16; const int s = row & 4095;
                const float sc = isk ? 0.0625f * exp2f(-(float)((s & 127) + 1) * l2g) : 1.0f;
                float o1[8], o2[8];
#pragma unroll
                for (int n = 0; n < 2; ++n) { const f32x4 cv = cvs[m][n], sv = svs[m][n];
                    const f32x4 t1 = acc[ai][0][m][n], t2 = acc[ai][1][m][n];
#pragma unroll
                    for (int e = 0; e < 4; ++e) { o1[n * 4 + e] = (t1[e] * cv[e] - t2[e] * sv[e]) * sc; o2[n * 4 + e] = (t1[e] * sv[e] + t2[e] * cv[e]) * sc; } }
                u32x4 w1, w2;
                w1.x = cvt_pk_bf16(o1[0], o1[1]); w1.y = cvt_pk_bf16(o1[2], o1[3]); w1.z = cvt_pk_bf16(o1[4], o1[5]); w1.w = cvt_pk_bf16(o1[6], o1[7]);
                w2.x = cvt_pk_bf16(o2[0], o2[1]); w2.y = cvt_pk_bf16(o2[2], o2[3]); w2.z = cvt_pk_bf16(o2[4], o2[5]); w2.w = cvt_pk_bf16(o2[6], o2[7]);
                bf16_t* rp = dst + (size_t)row * 2048;
                *(u32x4*)rp = w1; *(u32x4*)(rp + 128) = w2; }
        }
    }
};
struct EpiRetGate {
    static constexpr bool PERM = true;
    bf16_t* RO; const float* ssq;
    DI void operator()(const AccT& acc, const Unit& u, int wr, int wc, int fr, int fq) const {
        const int row0 = u.pm * 256 + wr * 64 + fr, col0 = u.pn * 256 + wc * 32 + 8 * fq, hd = u.pn >> 1;
#pragma unroll
        for (int ai = 0; ai < 2; ++ai) {
            f32x4 sq[4]; u32x4 ov[4][2];
#pragma unroll
            for (int m = 0; m < 4; ++m) { const int row = row0 + ai * 128 + m * 16; sq[m] = *(const f32x4*)(ssq + (size_t)row * 32 + hd * 4);
                const bf16_t* rowp = RO + (size_t)row * 4096 + col0; ov[m][0] = *(const u32x4*)rowp; ov[m][1] = *(const u32x4*)(rowp + 128); }
#pragma unroll
            for (int m = 0; m < 4; ++m) { const int row = row0 + ai * 128 + m * 16;
                const float rn = rsqrtf((sq[m][0] + sq[m][1] + sq[m][2] + sq[m][3]) * (1.0f / 512.0f) + NEPS);
                bf16_t* rowp = RO + (size_t)row * 4096 + col0;
#pragma unroll
                for (int bj = 0; bj < 2; ++bj) { const u32x4 o = ov[m][bj];
                    const f32x4 g0 = acc[ai][bj][m][0], g1 = acc[ai][bj][m][1];
                    u32x4 w;
                    w.x = cvt_pk_bf16(silu_f(g0[0]) * bf_lo(o.x) * rn, silu_f(g0[1]) * bf_hi(o.x) * rn);
                    w.y = cvt_pk_bf16(silu_f(g0[2]) * bf_lo(o.y) * rn, silu_f(g0[3]) * bf_hi(o.y) * rn);
                    w.z = cvt_pk_bf16(silu_f(g1[0]) * bf_lo(o.z) * rn, silu_f(g1[1]) * bf_hi(o.z) * rn);
                    w.w = cvt_pk_bf16(silu_f(g1[2]) * bf_lo(o.w) * rn, silu_f(g1[3]) * bf_hi(o.w) * rn);
                    *(u32x4*)(rowp + bj * 128) = w; } }
        }
    }
};

struct CJob { const float* src; bf16_t* dst; int ldsrc, K, nrows, mode, coff; };
DI void convert_w(const CJob j, LAS unsigned* lw) {
    const int tid = tidx(), ntR = j.nrows >> 6, ntK = j.K >> 7, total = ntR * ntK;
    const int nq = tid & 15, kr = tid >> 4;
    auto tile_src = [&](int tile) -> const float* { const int rt = tile % ntR, kt = tile / ntR, R0 = rt * 64, k0 = kt * 128;
        const int c0 = j.mode == 0 ? j.coff + R0 : ((R0 >> 7) & 1) * DFF + (R0 >> 8) * 128 + (R0 & 127);
        return j.src + (size_t)(k0 + 2 * kr) * j.ldsrc + c0 + 4 * nq; };
    f32x4 a[2][2], an[2][2];
    int tile = bidx();
    if (tile < total) { const float* sp = tile_src(tile);
#pragma unroll
        for (int p = 0; p < 2; ++p) { const float* s = sp + (size_t)(64 * p) * j.ldsrc; a[p][0] = *(const f32x4*)s; a[p][1] = *(const f32x4*)(s + j.ldsrc); } }
    for (; tile < total; tile += gridDim.x) {
        const int rt = tile % ntR, kt = tile / ntR, R0 = rt * 64, k0 = kt * 128;
        { const int tnext = tile + gridDim.x; const float* sp = tile_src(tnext < total ? tnext : tile);
#pragma unroll
            for (int p = 0; p < 2; ++p) { const float* s = sp + (size_t)(64 * p) * j.ldsrc; an[p][0] = *(const f32x4*)s; an[p][1] = *(const f32x4*)(s + j.ldsrc); } }
#pragma unroll
        for (int p = 0; p < 2; ++p) { const int kp = p * 32 + kr;
#pragma unroll
            for (int e = 0; e < 4; ++e) lw[(4 * nq + e) * 65 + kp] = cvt_pk_bf16(a[p][0][e], a[p][1][e]); }
        __syncthreads();
#pragma unroll
        for (int i = 0; i < 2; ++i) { const int idx = tid + 512 * i, n = idx >> 4, ch = idx & 15;
            u32x4 v; v.x = lw[n * 65 + 4 * ch]; v.y = lw[n * 65 + 4 * ch + 1]; v.z = lw[n * 65 + 4 * ch + 2]; v.w = lw[n * 65 + 4 * ch + 3];
            *(u32x4*)(j.dst + (size_t)(R0 + n) * j.K + k0 + 8 * ch) = v; }
        __syncthreads();
#pragma unroll
        for (int p = 0; p < 2; ++p) { a[p][0] = an[p][0]; a[p][1] = an[p][1]; }
    }
}
DI void convert_set(const Params& P, int set, LAS unsigned* lw) {
    const int njobs = set == 0 ? 4 : (set == 1 ? 3 : 2);
    for (int ji = 0; ji < njobs; ++ji) {
        CJob j;
        const int id = set * 4 + ji;
        switch (id) {
            case 0:  j = CJob{P.att_w_qkv, (bf16_t*)(P.ws + OFF_WQKV0), 18432, 2048, 18432, 0, 0}; break;
            case 1:  j = CJob{P.att_w_o, (bf16_t*)(P.ws + OFF_WO0), 2048, 2048, 2048, 0, 0}; break;
            case 2:  j = CJob{P.ffn_w_up, (bf16_t*)(P.ws + OFF_WUP0), 11264, 2048, 11264, 1, 0}; break;
            case 3:  j = CJob{P.ffn_w_down, (bf16_t*)(P.ws + OFF_WDN0), 2048, 5632, 2048, 0, 0}; break;
            case 4:  j = CJob{P.ret_w_qkvg, (bf16_t*)(P.ws + OFF_WRQKV), 12288, 2048, 8192, 0, 0}; break;
            case 5:  j = CJob{P.ret_w_qkvg, (bf16_t*)(P.ws + OFF_WRG), 12288, 2048, 4096, 0, 8192}; break;
            case 6:  j = CJob{P.ret_w_o, (bf16_t*)(P.ws + OFF_WRO), 2048, 4096, 2048, 0, 0}; break;
            case 8:  j = CJob{P.ffn_w_up + (size_t)2048 * 11264, (bf16_t*)(P.ws + OFF_WUP1), 11264, 2048, 11264, 1, 0}; break;
            default: j = CJob{P.ffn_w_down + (size_t)5632 * 2048, (bf16_t*)(P.ws + OFF_WDN1), 2048, 5632, 2048, 0, 0}; break;
        }
        convert_w(j, lw);
    }
}

DI void mod_gemv(const Params& P, LAS float* lf) {
    const int tid = tidx();
    if (bidx() >= 192) return;
    for (int i = tid; i < 8 * 2048; i += NTHREADS) lf[i] = silu_f(P.c[i]);
    __syncthreads();
    LAS float* red = lf + 16384;
    float* mod = (float*)(P.ws + OFF_MOD);
    const int cq = tid & 31, kg = tid >> 5;
    for (int item = bidx(); item < 192; item += gridDim.x) {
        const int l = item / 96, nb = item % 96;
        const float* w = P.w_mod + ((size_t)l * 2048 + kg * 128) * MODW + nb * 128 + cq * 4;
        f32x4 acc[8];
#pragma unroll
        for (int b = 0; b < 8; ++b) acc[b] = (f32x4){0.f, 0.f, 0.f, 0.f};
        const LAS float* cs = lf + kg * 128;
#pragma unroll 1
        for (int k0 = 0; k0 < 128; k0 += 8) {
            f32x4 wv[8];
#pragma unroll
            for (int kk = 0; kk < 8; ++kk) wv[kk] = *(const f32x4*)(w + (size_t)(k0 + kk) * MODW);
#pragma unroll
            for (int kk = 0; kk < 8; ++kk)
#pragma unroll
                for (int b = 0; b < 8; ++b) acc[b] += wv[kk] * cs[b * 2048 + k0 + kk];
        }
#pragma unroll
        for (int b = 0; b < 8; ++b) *(LAS f32x4*)(red + (kg * 8 + b) * 128 + cq * 4) = acc[b];
        __syncthreads();
        for (int i = tid; i < 1024; i += NTHREADS) { const int b = i >> 7, cc = i & 127;
            float sum = 0.f;
#pragma unroll
            for (int g = 0; g < 16; ++g) sum += red[(g * 8 + b) * 128 + cc];
            mod[(size_t)(l * 8 + b) * MODW + nb * 128 + cc] = sum + P.b_mod[l * MODW + nb * 128 + cc]; }
        __syncthreads();
    }
}
DI void rotary_tables(const Params& P) {
    float* cosT = (float*)(P.ws + OFF_COS); float* sinT = (float*)(P.ws + OFF_SIN);
    for (int i = bidx() * NTHREADS + tidx(); i < 4096 * 128; i += gridDim.x * NTHREADS) {
        const int s = i >> 7, jx = i & 127;
        const float inv = 1.0f / exp2f((float)jx * (13.287712379549449f / 127.0f));
        const float ang = (float)s * inv;
        const float nn = rintf(ang * 0.15915494309189535f);
        float r = fmaf(-nn, 6.2831854820251465f, ang); r = fmaf(-nn, -1.7484555e-07f, r);
        cosT[i] = __cosf(r); sinT[i] = __sinf(r);
    }
}

template <bool SRCBF> DI void norm_phase(const Params& P, int l, int which) {
    const float* src = (l == 0 && which == 0) ? P.x : P.out;
    const bf16_t* srcb = (const bf16_t*)(P.ws + (l == 0 ? OFF_XB1 : OFF_XB3));
    const float* gain = (which ? P.norm_ffn : P.norm_mix) + l * DM;
    const float* mod = (const float*)(P.ws + OFF_MOD) + (size_t)l * 8 * MODW;
    bf16_t* H = (bf16_t*)(P.ws + OFF_H);
    const int lane = tidx() & 63, gw = bidx() * 8 + (tidx() >> 6), nw = gridDim.x * 8;
    for (int blk = gw; blk < TTOK / 16; blk += nw) {
        const int rbase = blk * 16, b = rbase >> 12;
        const float* sh = mod + (size_t)b * MODW + (which ? 3 : 0) * DM; const float* sc = mod + (size_t)b * MODW + (which ? 4 : 1) * DM;
        f32x4 av[8], hv[8];
#pragma unroll
        for (int i = 0; i < 8; ++i) { const int cc = 4 * lane + 256 * i; const f32x4 gv = *(const f32x4*)(gain + cc), sv = *(const f32x4*)(sc + cc); hv[i] = *(const f32x4*)(sh + cc);
#pragma unroll
            for (int e = 0; e < 4; ++e) av[i][e] = gv[e] * (1.0f + sv[e]); }
#pragma unroll 1
        for (int rp = 0; rp < 8; ++rp) {
            const int row0 = rbase + 2 * rp;
            f32x4 v[2][8]; float ss0 = 0.f, ss1 = 0.f;
            if constexpr (SRCBF) { const bf16_t* xb = srcb + (size_t)row0 * DM;
#pragma unroll
                for (int i = 0; i < 8; ++i) { const u32x2 t0 = *(const u32x2*)(xb + 4 * lane + 256 * i), t1 = *(const u32x2*)(xb + DM + 4 * lane + 256 * i);
                    v[0][i] = (f32x4){bf_lo(t0.x), bf_hi(t0.x), bf_lo(t0.y), bf_hi(t0.y)}; v[1][i] = (f32x4){bf_lo(t1.x), bf_hi(t1.x), bf_lo(t1.y), bf_hi(t1.y)}; } }
            else { const float* xr = src + (size_t)row0 * DM;
#pragma unroll
                for (int i = 0; i < 8; ++i) { v[0][i] = *(const f32x4*)(xr + 4 * lane + 256 * i); v[1][i] = *(const f32x4*)(xr + DM + 4 * lane + 256 * i); } }
#pragma unroll
            for (int i = 0; i < 8; ++i) { ss0 += v[0][i][0] * v[0][i][0] + v[0][i][1] * v[0][i][1] + v[0][i][2] * v[0][i][2] + v[0][i][3] * v[0][i][3];
                ss1 += v[1][i][0] * v[1][i][0] + v[1][i][1] * v[1][i][1] + v[1][i][2] * v[1][i][2] + v[1][i][3] * v[1][i][3]; }
            ss0 += shx(ss0, 1); ss1 += shx(ss1, 1); ss0 += shx(ss0, 2); ss1 += shx(ss1, 2); ss0 += shx(ss0, 4); ss1 += shx(ss1, 4);
            ss0 += shx(ss0, 8); ss1 += shx(ss1, 8); ss0 += shx(ss0, 16); ss1 += shx(ss1, 16); ss0 += shx(ss0, 32); ss1 += shx(ss1, 32);
            const float rs0 = rsqrtf(ss0 * (1.0f / 2048.0f) + NEPS), rs1 = rsqrtf(ss1 * (1.0f / 2048.0f) + NEPS);
            bf16_t* hr = H + (size_t)row0 * DM;
#pragma unroll
            for (int i = 0; i < 8; ++i) { const int cc = 4 * lane + 256 * i;
                f32x4 o0, o1;
#pragma unroll
                for (int e = 0; e < 4; ++e) { o0[e] = v[0][i][e] * rs0 * av[i][e] + hv[i][e]; o1[e] = v[1][i][e] * rs1 * av[i][e] + hv[i][e]; }
                u32x2 w0, w1; w0.x = cvt_pk_bf16(o0[0], o0[1]); w0.y = cvt_pk_bf16(o0[2], o0[3]); w1.x = cvt_pk_bf16(o1[0], o1[1]); w1.y = cvt_pk_bf16(o1[2], o1[3]);
                *(u32x2*)(hr + cc) = w0; *(u32x2*)(hr + DM + cc) = w1; }
        }
    }
}
DI int t5_bucket(int dist) {
    if (dist < 16) return dist;
    const float v = logf((float)dist / 16.0f) / 4.852030263919617f * 16.0f;
    const int lg = 16 + (int)v;
    return lg < 31 ? lg : 31;
}
#define MFMA16(a, b, c) __builtin_amdgcn_mfma_f32_16x16x32_bf16((a), (b), (c), 0, 0, 0)
DI bf16x8 gather_col(const LAS unsigned char* p0, const LAS unsigned char* p1, int stride) {
    bf16x8 r;
    r[0] = *(const LAS short*)(p0); r[1] = *(const LAS short*)(p0 + stride); r[2] = *(const LAS short*)(p0 + 2 * stride); r[3] = *(const LAS short*)(p0 + 3 * stride);
    r[4] = *(const LAS short*)(p1); r[5] = *(const LAS short*)(p1 + stride); r[6] = *(const LAS short*)(p1 + 2 * stride); r[7] = *(const LAS short*)(p1 + 3 * stride);
    return r;
}
typedef short s16x4 __attribute__((ext_vector_type(4)));
DI bf16x8 tr_frag(const LAS unsigned char* p0, const LAS unsigned char* p1) {
    const s16x4 lo = __builtin_amdgcn_ds_read_tr16_b64_v4i16((LAS s16x4*)p0), hi = __builtin_amdgcn_ds_read_tr16_b64_v4i16((LAS s16x4*)p1);
    return __builtin_shufflevector(lo, hi, 0, 1, 2, 3, 4, 5, 6, 7);
}
DI bf16x8 pack8(const float* f) { u32x4 w; w.x = cvt_pk_bf16(f[0], f[1]); w.y = cvt_pk_bf16(f[2], f[3]); w.z = cvt_pk_bf16(f[4], f[5]); w.w = cvt_pk_bf16(f[6], f[7]); return __builtin_bit_cast(bf16x8, w); }

#define ATT_RAW_BAR() do { asm volatile("s_waitcnt lgkmcnt(0)" ::: "memory"); __builtin_amdgcn_s_barrier(); asm volatile("" ::: "memory"); } while (0)
DI void attn_phase(const Params& P, LAS unsigned char* L) {
    const bf16_t* QKV = (const bf16_t*)(P.ws + OFF_QKVC);
    bf16_t* OG = (bf16_t*)(P.ws + OFF_OG); float* LSE = (float*)(P.ws + OFF_LSE);
    const int tid = tidx(), lane = tid & 63, w = __builtin_amdgcn_readfirstlane(tid >> 6), fr = lane & 15, fq = lane >> 4;
    LAS unsigned char* Ks = L; LAS unsigned char* Vs = L + 65536; LAS float* biasL = (LAS float*)(L + 131072);
    const int ch = tid & 15, krow = tid >> 4;
    int vtr[8];
#pragma unroll
    for (int dt = 0; dt < 8; ++dt) vtr[dt] = (4 * fq + (fr >> 2)) * 256 + ((dt ^ (4 * (fq & 1) + (fr >> 2))) << 5) + (fr & 3) * 8;
    for (int sg = bidx(); sg < 768; sg += gridDim.x) {
        const int it0 = sg * 4;
        const int blk0 = it0 & 31, h = (it0 >> 5) & 15, gb = it0 >> 9, g = gb % 3, bb = gb / 3;
        const int l2d = 2 * g, dil = 1 << l2d, nbl2 = 5 - l2d, nbm = (32 >> l2d) - 1;
        const size_t rowbase = (size_t)bb * 4096;
        const int colq = g * 6144 + h * 128;
        const bf16_t* qkv_c = QKV + colq;
        const f32x4 kg0 = *(const f32x4*)(P.att_k_gain + g * 128 + ch * 8), kg1 = *(const f32x4*)(P.att_k_gain + g * 128 + ch * 8 + 4);
        u32x4 ka[4], va[4], qraw[4], qnext[4];
        auto load_block = [&](int r_, int n_) {
#pragma unroll
            for (int i = 0; i < 4; ++i) { const int idx = n_ * 128 + krow + 32 * i;
                const bf16_t* p = qkv_c + (rowbase + (size_t)idx * dil + r_) * 18432 + ch * 8; ka[i] = *(const u32x4*)(p + 2048); va[i] = *(const u32x4*)(p + 4096); } };
        auto stage_block = [&](int half) {
#pragma unroll
            for (int i = 0; i < 4; ++i) { const int row = half * 128 + krow + 32 * i; const u32x4 kv = ka[i];
                float f[8] = {bf_lo(kv.x), bf_hi(kv.x), bf_lo(kv.y), bf_hi(kv.y), bf_lo(kv.z), bf_hi(kv.z), bf_lo(kv.w), bf_hi(kv.w)};
                float ss = 0.f;
#pragma unroll
                for (int e = 0; e < 8; ++e) ss += f[e] * f[e];
                ss += shx(ss, 1); ss += shx(ss, 2); ss += shx(ss, 4); ss += shx(ss, 8);
                const float rk = rsqrtf(ss * (1.0f / 128.0f) + NEPS);
#pragma unroll
                for (int e = 0; e < 4; ++e) { f[e] *= rk * kg0[e]; f[4 + e] *= rk * kg1[e]; }
                *(LAS bf16x8*)(Ks + row * 256 + ((ch ^ (row & 15)) << 4)) = pack8(f);
                *(LAS u32x4*)(Vs + row * 256 + (((ch >> 1) ^ (row & 7)) << 5) + (ch & 1) * 16) = va[i]; } };
        auto load_q = [&](int r_, int n_, u32x4* dst) {
            const size_t qrow_ = rowbase + (size_t)(n_ * 128 + 16 * w + fr) * dil + r_;
            const bf16_t* qp = qkv_c + qrow_ * 18432 + 8 * fq;
#pragma unroll
            for (int ks = 0; ks < 4; ++ks) dst[ks] = *(const u32x4*)(qp + 32 * ks); };
        const int r0 = blk0 >> nbl2, n0 = blk0 & nbm;
        if (tid < 129) { const int bk = t5_bucket(tid * dil); biasL[tid] = P.rel_bias[bk * 48 + g * 16 + h] * LOG2E; }
        if (tid >= 256 && tid < 384) biasL[132 + tid - 256] = P.att_q_gain[g * 128 + tid - 256];
        if (n0 > 0) { load_block(r0, n0 - 1); stage_block((n0 - 1) & 1); }
        else {
#pragma unroll
            for (int i = 0; i < 4; ++i) { const int row = 128 + krow + 32 * i; *(LAS u32x4*)(Ks + row * 256 + ch * 16) = (u32x4){0u, 0u, 0u, 0u}; *(LAS u32x4*)(Vs + row * 256 + ch * 16) = (u32x4){0u, 0u, 0u, 0u}; } }
        load_block(r0, n0); stage_block(n0 & 1);
        load_q(r0, n0, qraw);
        __syncthreads();
#pragma unroll 1
        for (int i4 = 0; i4 < 4; ++i4) {
            const int blk = blk0 + i4, r = blk >> nbl2, n = blk & nbm;
            const int blkn = blk + 1, rn = blkn >> nbl2, nn = blkn & nbm;
            const size_t qrow = rowbase + (size_t)(n * 128 + 16 * w + fr) * dil + r;
            bf16x8 qf[4];
            {
                float ss = 0.f;
#pragma unroll
                for (int ks = 0; ks < 4; ++ks) {
                    const float f[8] = {bf_lo(qraw[ks].x), bf_hi(qraw[ks].x), bf_lo(qraw[ks].y), bf_hi(qraw[ks].y), bf_lo(qraw[ks].z), bf_hi(qraw[ks].z), bf_lo(qraw[ks].w), bf_hi(qraw[ks].w)};
#pragma unroll
                    for (int e = 0; e < 8; ++e) ss += f[e] * f[e]; }
                ss += shx(ss, 16); ss += shx(ss, 32);
                const float rq = rsqrtf(ss * (1.0f / 128.0f) + NEPS) * (0.08838834764831845f * LOG2E);
#pragma unroll
                for (int ks = 0; ks < 4; ++ks) { const LAS float* gp = biasL + 132 + 32 * ks + 8 * fq; const f32x4 g0 = *(const LAS f32x4*)gp, g1 = *(const LAS f32x4*)(gp + 4);
                    float f[8] = {bf_lo(qraw[ks].x), bf_hi(qraw[ks].x), bf_lo(qraw[ks].y), bf_hi(qraw[ks].y), bf_lo(qraw[ks].z), bf_hi(qraw[ks].z), bf_lo(qraw[ks].w), bf_hi(qraw[ks].w)};
#pragma unroll
                    for (int e = 0; e < 4; ++e) { f[e] *= rq * g0[e]; f[4 + e] *= rq * g1[e]; }
                    qf[ks] = pack8(f); }
            }
            if (i4 < 3) { load_block(rn, nn); load_q(rn, nn, qnext); }
            f32x4 sc[9];
            {
                bf16x8 kfa[2][4];
                auto load_kf = [&](int tt, bf16x8* dst) { const int t = w + tt; const int row = (((n + 1 + (t >> 3)) & 1) << 7) + ((t & 7) << 4) + fr;
#pragma unroll
                    for (int ks = 0; ks < 4; ++ks) dst[ks] = *(const LAS bf16x8*)(Ks + row * 256 + (((4 * ks + fq) ^ fr) << 4)); };
                load_kf(0, kfa[0]);
#pragma unroll
                for (int tt = 0; tt < 9; ++tt) {
                    if (tt + 1 < 9) load_kf(tt + 1, kfa[(tt + 1) & 1]);
                    __builtin_amdgcn_sched_barrier(0);
                    f32x4 a = (f32x4){0.f, 0.f, 0.f, 0.f};
#pragma unroll
                    for (int ks = 0; ks < 4; ++ks) a = MFMA16(kfa[tt & 1][ks], qf[ks], a);
                    sc[tt] = a;
                    __builtin_amdgcn_sched_barrier(0);
                }
            }
            float mx = -3.0e38f;
#pragma unroll
            for (int tt = 0; tt < 9; ++tt)
#pragma unroll
                for (int j = 0; j < 4; ++j) { const int delta = 128 + fr - 16 * tt - 4 * fq - j; const int ki = 16 * (w + tt) + 4 * fq + j;
                    const bool valid = (delta >= 0) && (delta <= 128) && (n > 0 || ki >= 128);
                    const int dc = delta < 0 ? 0 : (delta > 128 ? 128 : delta);
                    const float s = valid ? sc[tt][j] + biasL[dc] : -1.0e30f;
                    sc[tt][j] = s; mx = fmaxf(mx, s); }
            mx = fmaxf(mx, shx(mx, 16)); mx = fmaxf(mx, shx(mx, 32));
            float sum = 0.f;
#pragma unroll
            for (int tt = 0; tt < 9; ++tt)
#pragma unroll
                for (int j = 0; j < 4; ++j) { const float p = __builtin_amdgcn_exp2f(sc[tt][j] - mx); sc[tt][j] = p; sum += p; }
            sum += shx(sum, 16); sum += shx(sum, 32);
            f32x4 oacc[8];
#pragma unroll
            for (int dt = 0; dt < 8; ++dt) oacc[dt] = (f32x4){0.f, 0.f, 0.f, 0.f};
            bf16x8 pb[5];
#pragma unroll
            for (int s2 = 0; s2 < 5; ++s2) { float pf[8];
#pragma unroll
                for (int j = 0; j < 4; ++j) { pf[j] = sc[2 * s2][j]; pf[4 + j] = (2 * s2 + 1 <= 8) ? sc[(2 * s2 + 1 <= 8) ? 2 * s2 + 1 : 8][j] : 0.f; }
                pb[s2] = pack8(pf); }
            {
                bf16x8 vfa[2][2];
                auto load_vf = [&](int hb, bf16x8* dst) { const int s2 = hb >> 2, dh = (hb & 3) * 2;
                    const int t0 = w + 2 * s2; int t1 = w + 2 * s2 + 1; t1 = t1 > 15 ? 15 : t1;
                    const int rw0 = (((n + 1 + (t0 >> 3)) & 1) << 7) + ((t0 & 7) << 4), rw1 = (((n + 1 + (t1 >> 3)) & 1) << 7) + ((t1 & 7) << 4);
                    const LAS unsigned char* v0 = Vs + rw0 * 256; const LAS unsigned char* v1 = Vs + rw1 * 256;
#pragma unroll
                    for (int d = 0; d < 2; ++d) dst[d] = tr_frag(v0 + vtr[dh + d], v1 + vtr[dh + d]); };
                load_vf(0, vfa[0]);
#pragma unroll
                for (int hb = 0; hb < 20; ++hb) {
                    if (hb + 1 < 20) load_vf(hb + 1, vfa[(hb + 1) & 1]);
                    __builtin_amdgcn_sched_barrier(0);
#pragma unroll
                    for (int d = 0; d < 2; ++d) oacc[(hb & 3) * 2 + d] = MFMA16(vfa[hb & 1][d], pb[hb >> 2], oacc[(hb & 3) * 2 + d]);
                    __builtin_amdgcn_sched_barrier(0);
                }
            }
            const float inv = 1.0f / sum;
            bf16_t* op = OG + ((size_t)g * 8192 + qrow) * 2048 + h * 128 + 4 * fq;
#pragma unroll
            for (int dt = 0; dt < 8; ++dt) { u32x2 wv; wv.x = cvt_pk_bf16(oacc[dt][0] * inv, oacc[dt][1] * inv); wv.y = cvt_pk_bf16(oacc[dt][2] * inv, oacc[dt][3] * inv); *(u32x2*)(op + 16 * dt) = wv; }
            if (fq == 0) LSE[((size_t)g * 8192 + qrow) * 16 + h] = mx + __log2f(sum);
            ATT_RAW_BAR();
            if (i4 < 3) { stage_block(nn & 1);
#pragma unroll
                for (int ks = 0; ks < 4; ++ks) qraw[ks] = qnext[ks]; }
            ATT_RAW_BAR();
        }
    }
}
DI void merge_phase(const Params& P, int cb) {
    const bf16_t* OG = (const bf16_t*)(P.ws + OFF_OG); const float* LSE = (const float*)(P.ws + OFF_LSE);
    bf16_t* O = (bf16_t*)(P.ws + OFF_O) + (size_t)cb * 8192 * 2048;
    const int tid = tidx();
    const int c8 = (tid & 255) * 8, h = c8 >> 7;
    for (int pr0 = bidx() * 4; pr0 < 4096; pr0 += gridDim.x * 4) {
        float l[4][3]; u32x4 a[4][3];
#pragma unroll
        for (int q = 0; q < 4; ++q) { const int tok = (pr0 + q) * 2 + (tid >> 8);
#pragma unroll
            for (int g = 0; g < 3; ++g) { l[q][g] = LSE[((size_t)g * 8192 + tok) * 16 + h]; a[q][g] = *(const u32x4*)(OG + ((size_t)g * 8192 + tok) * 2048 + c8); } }
#pragma unroll
        for (int q = 0; q < 4; ++q) { const int tok = (pr0 + q) * 2 + (tid >> 8);
            const float m = fmaxf(l[q][0], fmaxf(l[q][1], l[q][2]));
            float w0 = __builtin_amdgcn_exp2f(l[q][0] - m), w1 = __builtin_amdgcn_exp2f(l[q][1] - m), w2 = __builtin_amdgcn_exp2f(l[q][2] - m);
            const float inv = 1.0f / (w0 + w1 + w2); w0 *= inv; w1 *= inv; w2 *= inv;
            const u32x4 x = a[q][0], y = a[q][1], z = a[q][2];
            u32x4 o;
            o.x = cvt_pk_bf16(w0 * bf_lo(x.x) + w1 * bf_lo(y.x) + w2 * bf_lo(z.x), w0 * bf_hi(x.x) + w1 * bf_hi(y.x) + w2 * bf_hi(z.x));
            o.y = cvt_pk_bf16(w0 * bf_lo(x.y) + w1 * bf_lo(y.y) + w2 * bf_lo(z.y), w0 * bf_hi(x.y) + w1 * bf_hi(y.y) + w2 * bf_hi(z.y));
            o.z = cvt_pk_bf16(w0 * bf_lo(x.z) + w1 * bf_lo(y.z) + w2 * bf_lo(z.z), w0 * bf_hi(x.z) + w1 * bf_hi(y.z) + w2 * bf_hi(z.z));
            o.w = cvt_pk_bf16(w0 * bf_lo(x.w) + w1 * bf_lo(y.w) + w2 * bf_lo(z.w), w0 * bf_hi(x.w) + w1 * bf_hi(y.w) + w2 * bf_hi(z.w));
            *(u32x4*)(O + (size_t)tok * 2048 + c8) = o; }
    }
}
DI int swz32(int chunk, int row) { return (((chunk & 15) ^ (row & 15)) | (chunk & 16)) << 4; }
#define RAW_BAR() do { asm volatile("s_waitcnt lgkmcnt(0)" ::: "memory"); __builtin_amdgcn_s_barrier(); asm volatile("" ::: "memory"); } while (0)
DI void scan_phase(const Params& P, LAS unsigned char* L) {
    const bf16_t* RQ = (const bf16_t*)(P.ws + OFF_RQ); const bf16_t* RK = (const bf16_t*)(P.ws + OFF_RK); const bf16_t* RV = (const bf16_t*)(P.ws + OFF_RV);
    bf16_t* RO = (bf16_t*)(P.ws + OFF_RO); float* SSQ = (float*)(P.ws + OFF_SSQ);
    const int tid = tidx(), lane = tid & 63, w = __builtin_amdgcn_readfirstlane(tid >> 6), fr = lane & 15, fq = lane >> 4;
    LAS unsigned char* S = L; LAS unsigned char* Kb = L + 65536; LAS unsigned char* Vs = L + 131072;
    int xb[4], ktr[2], wb[2], vtr[8];
    const int q4 = fr >> 2, p4 = fr & 3;
#pragma unroll
    for (int a = 0; a < 4; ++a) xb[a] = fr * 512 + (((4 * a + fq) ^ fr) << 4);
#pragma unroll
    for (int a = 0; a < 2; ++a) {
        ktr[a] = (4 * fq + q4) * 512 + ((((4 * w + 2 * a + (p4 >> 1)) & 15) ^ (4 * fq + q4)) << 4) + ((w >> 2) << 8) + (p4 & 1) * 8;
        wb[a] = fr * 512 + ((((4 * w + 2 * a + (fq >> 1)) & 15) ^ fr) << 4) + ((w >> 2) << 8) + (fq & 1) * 8; }
#pragma unroll
    for (int vt = 0; vt < 8; ++vt) vtr[vt] = (4 * fq + q4) * 256 + ((vt ^ (4 * (fq & 1) + q4)) << 5) + p4 * 8;
    const int km = lane >> 5, kcp = lane & 31;
    const int vm = lane >> 4, vcp = lane & 15;
    const unsigned kgo = (unsigned)(km * 2048 + ((kcp & 16) | ((kcp & 15) ^ ((2 * w + km) & 15))) * 8);
    const unsigned vgo = (unsigned)(vm * 4096 + ((((vcp >> 1) ^ ((4 * w + vm) & 7)) << 1) | (vcp & 1)) * 8);
    for (int it = bidx(); it < 256; it += gridDim.x) {
        const int vs = it & 3, h = (it >> 2) & 7, b = it >> 5;
        const float l2g = __log2f(1.0f - exp2f(-5.0f - (float)h));
        const float gC = exp2f(128.0f * l2g);
        f32x4 sacc[2][8];
#pragma unroll
        for (int a = 0; a < 2; ++a)
#pragma unroll
            for (int v = 0; v < 8; ++v) sacc[a][v] = (f32x4){0.f, 0.f, 0.f, 0.f};
        __syncthreads();
#pragma unroll
        for (int i = 0; i < 8; ++i) *(LAS u32x4*)(S + (tid + 512 * i) * 16) = (u32x4){0u, 0u, 0u, 0u};
        auto stage_kv = [&](size_t t0) {
#pragma unroll
            for (int i = 0; i < 8; ++i) { const bf16_t* kp = RK + (t0 + 16 * i + 2 * w) * 2048 + h * 256;
                __builtin_amdgcn_global_load_lds((const unsigned*)(kp + kgo), (LAS unsigned*)(Kb + (i * 8 + w) * 1024), 16, 0, 0); }
#pragma unroll
            for (int i = 0; i < 4; ++i) { const bf16_t* vp = RV + (t0 + 32 * i + 4 * w) * 4096 + h * 512 + vs * 128;
                __builtin_amdgcn_global_load_lds((const unsigned*)(vp + vgo), (LAS unsigned*)(Vs + (i * 8 + w) * 1024), 16, 0, 0); } };
        bf16x8 qf[8];
        auto load_q = [&](size_t t0) { const bf16_t* qp = RQ + (t0 + 16 * w) * 2048 + h * 256; const unsigned qo = (unsigned)(fr * 2048 + 8 * fq);
#pragma unroll
            for (int ks = 0; ks < 8; ++ks) qf[ks] = *(const bf16x8*)(qp + (qo + 32 * ks)); };
        load_q((size_t)b * 4096); stage_kv((size_t)b * 4096);
        __syncthreads();
        for (int c = 0; c < 32; ++c) {
            const size_t t0 = (size_t)b * 4096 + c * 128;
            f32x4 oacc[8];
#pragma unroll
            for (int vt = 0; vt < 8; ++vt) { f32x4 a = (f32x4){0.f, 0.f, 0.f, 0.f}; bf16x8 sfa[8];
#pragma unroll
                for (int ks = 0; ks < 8; ++ks) sfa[ks] = *(const LAS bf16x8*)(S + vt * 8192 + xb[ks & 3] + (ks >> 2) * 256);
                __builtin_amdgcn_sched_barrier(0);
#pragma unroll
                for (int ks = 0; ks < 8; ++ks) a = MFMA16(sfa[ks], qf[ks], a);
                oacc[vt] = a; }
            asm volatile("s_waitcnt vmcnt(0)" ::: "memory");
            RAW_BAR();
            unsigned pk[8][2];
#pragma unroll
            for (int mt = 0; mt < 8; ++mt) {
                f32x4 a = (f32x4){0.f, 0.f, 0.f, 0.f};
                if (mt <= w) {
                    bf16x8 kfa[8];
#pragma unroll
                    for (int ks = 0; ks < 8; ++ks) kfa[ks] = *(const LAS bf16x8*)(Kb + mt * 8192 + xb[ks & 3] + (ks >> 2) * 256);
                    __builtin_amdgcn_sched_barrier(0);
#pragma unroll
                    for (int ks = 0; ks < 8; ++ks) a = MFMA16(kfa[ks], qf[ks], a);
#pragma unroll
                    for (int j = 0; j < 4; ++j) a[j] = (mt < w || 4 * fq + j <= fr) ? a[j] : 0.f; }
                pk[mt][0] = cvt_pk_bf16(a[0], a[1]); pk[mt][1] = cvt_pk_bf16(a[2], a[3]); }
            const size_t tn = t0 + (c + 1 < 32 ? 128 : 0);
            load_q(tn);
#pragma unroll
            for (int ms = 0; ms < 4; ++ms) {
                u32x4 pw; pw.x = pk[2 * ms][0]; pw.y = pk[2 * ms][1]; pw.z = pk[2 * ms + 1][0]; pw.w = pk[2 * ms + 1][1];
                const bf16x8 pb = __builtin_bit_cast(bf16x8, pw);
                const LAS unsigned char* k0 = Kb + (32 * ms) * 512; const LAS unsigned char* v0 = Vs + (32 * ms) * 256;
                const bf16x8 kf0 = tr_frag(k0 + ktr[0], k0 + 16 * 512 + ktr[0]), kf1 = tr_frag(k0 + ktr[1], k0 + 16 * 512 + ktr[1]);
#pragma unroll
                for (int vt = 0; vt < 8; ++vt) { const bf16x8 vf = tr_frag(v0 + vtr[vt], v0 + 16 * 256 + vtr[vt]);
                    if (2 * ms <= w) oacc[vt] = MFMA16(vf, pb, oacc[vt]);
                    sacc[0][vt] = MFMA16(kf0, vf, sacc[0][vt]); sacc[1][vt] = MFMA16(kf1, vf, sacc[1][vt]); }
            }
            {
                const float dn = exp2f((float)(16 * w + fr + 1) * l2g);
                bf16_t* op = RO + (t0 + 16 * w) * 4096 + h * 512 + vs * 128 + (unsigned)(fr * 4096 + 4 * fq);
                float ss = 0.f;
#pragma unroll
                for (int vt = 0; vt < 8; ++vt) { const f32x4 o = oacc[vt] * dn; ss += o[0] * o[0] + o[1] * o[1] + o[2] * o[2] + o[3] * o[3];
                    u32x2 wv; wv.x = cvt_pk_bf16(o[0], o[1]); wv.y = cvt_pk_bf16(o[2], o[3]); *(u32x2*)(op + 16 * vt) = wv; }
                ss += shx(ss, 16); ss += shx(ss, 32);
                if (fq == 0) (SSQ + (t0 + 16 * w) * 32 + h * 4 + vs)[(unsigned)(fr * 32)] = ss;
            }
#pragma unroll
            for (int a = 0; a < 2; ++a)
#pragma unroll
                for (int v = 0; v < 8; ++v) sacc[a][v] *= gC;
            RAW_BAR();
#pragma unroll
            for (int ks = 0; ks < 8; ++ks) asm volatile("" :: "v"(qf[ks]));
            stage_kv(tn);
#pragma unroll
            for (int a = 0; a < 2; ++a)
#pragma unroll
                for (int vt = 0; vt < 8; ++vt) {
                    u32x2 wv; wv.x = cvt_pk_bf16(sacc[a][vt][0], sacc[a][vt][1]); wv.y = cvt_pk_bf16(sacc[a][vt][2], sacc[a][vt][3]);
                    *(LAS u32x2*)(S + vt * 8192 + wb[a]) = wv; }
            RAW_BAR();
        }
    }
}

constexpr int NPH = 23;
constexpr int MAXPH = NPH;
DI void decode_phase(int ph, int& type, int& a0, int& a1, int& a2) {
    a0 = 0; a1 = 0; a2 = -1;
    if (ph == 0) type = 0;
    else if (ph == 1) { type = 1; }
    else if (ph < 10) { const int q = (ph - 2) >> 1; a0 = q; if ((ph - 2) & 1) type = 3; else { type = 2; a1 = q > 0 ? 1 : 0; } }
    else if (ph == 10) { type = 4; a0 = 3; }
    else if (ph == 11) { type = 5; a0 = 0; }
    else if (ph == 12) { type = 1; a0 = 0; a1 = 1; }
    else if (ph == 13) { type = 6; a0 = 0; }
    else if (ph == 14) { type = 5; a0 = 1; }
    else if (ph == 15) { type = 1; a0 = 1; a1 = 0; a2 = 1; }
    else if (ph == 16) type = 7;
    else if (ph == 17) type = 8;
    else if (ph == 18) type = 9;
    else if (ph == 19) { type = 5; a0 = 2; }
    else if (ph == 20) { type = 1; a0 = 1; a1 = 1; a2 = 2; }
    else if (ph == 21) { type = 6; a0 = 1; }
    else { type = 5; a0 = 3; }
}
template <int TYPE> DI void run_phase(const Params& P, int a0, int a1, int a2, LAS unsigned char* L) {
    unsigned char* ws = P.ws; const float* mod = (const float*)(ws + OFF_MOD);
    pg8::StaticOrder S;
    if constexpr (TYPE == 0) { mod_gemv(P, (LAS float*)L); rotary_tables(P); __syncthreads(); convert_set(P, 0, (LAS unsigned*)L); }
    else if constexpr (TYPE == 1) { if (a2 >= 0) convert_set(P, a2, (LAS unsigned*)L); if (a1) norm_phase<true>(P, a0, a1); else norm_phase<false>(P, a0, a1); }
    else if constexpr (TYPE == 2) { if (a1) merge_phase(P, a0 - 1);
        pg8::Gemm g{(const bf16_t*)(ws + OFF_H) + (size_t)a0 * 8192 * 2048, (const bf16_t*)(ws + OFF_WQKV0), 8192, 18432, 2048};
        S.init(g.M, g.N, gridDim.x, bidx(), 4); EpiPlainBf16 E{(bf16_t*)(ws + OFF_QKVC), 18432};
        pg8::gemm_phase<EpiPlainBf16, pg8::StaticOrder>(L, g, S, E); }
    else if constexpr (TYPE == 3) attn_phase(P, L);
    else if constexpr (TYPE == 4) merge_phase(P, a0);
    else if constexpr (TYPE == 5) {
        const size_t offA = a0 == 0 ? OFF_O : (a0 == 1 ? OFF_HID0 : (a0 == 2 ? OFF_RO : OFF_HID1));
        const size_t offB = a0 == 0 ? OFF_WO0 : (a0 == 1 ? OFF_WDN0 : (a0 == 2 ? OFF_WRO : OFF_WDN1));
        const int kk = a0 == 0 ? 2048 : (a0 == 2 ? 4096 : DFF);
        const int goff = ((a0 >= 2) ? 8 * MODW : 0) + ((a0 & 1) ? 5 * DM : 2 * DM);
        pg8::Gemm g{(const bf16_t*)(ws + offA), (const bf16_t*)(ws + offB), TTOK, DM, kk};
        S.init(g.M, g.N, gridDim.x, bidx(), 4);
        if ((a0 & 1) == 0) {
            EpiResidF2B E{a0 == 0 ? P.x : P.out, (bf16_t*)(ws + (a0 == 0 ? OFF_XB1 : OFF_XB3)), mod + goff};
            pg8::gemm_phase<EpiResidF2B, pg8::StaticOrder>(L, g, S, E); }
        else {
            EpiResidB2F E{(const bf16_t*)(ws + (a0 == 1 ? OFF_XB1 : OFF_XB3)), P.out, mod + goff};
            pg8::gemm_phase<EpiResidB2F, pg8::StaticOrder>(L, g, S, E); } }
    else if constexpr (TYPE == 6) { pg8::Gemm g{(const bf16_t*)(ws + OFF_H), (const bf16_t*)(ws + (a0 ? OFF_WUP1 : OFF_WUP0)), TTOK, 2 * DFF, 2048};
        S.init(g.M, g.N, gridDim.x, bidx()); EpiSwiGLU E{(bf16_t*)(ws + (a0 ? OFF_HID1 : OFF_HID0))};
        pg8::gemm_phase<EpiSwiGLU, pg8::StaticOrder>(L, g, S, E); }
    else if constexpr (TYPE == 7) { pg8::Gemm g{(const bf16_t*)(ws + OFF_H), (const bf16_t*)(ws + OFF_WRQKV), TTOK, 8192, 2048};
        S.init(g.M, g.N, gridDim.x, bidx());
        EpiRetQKV E{(bf16_t*)(ws + OFF_RQ), (bf16_t*)(ws + OFF_RK), (bf16_t*)(ws + OFF_RV), (const float*)(ws + OFF_COS), (const float*)(ws + OFF_SIN)};
        pg8::gemm_phase<EpiRetQKV, pg8::StaticOrder>(L, g, S, E); }
    else if constexpr (TYPE == 8) scan_phase(P, L);
    else { pg8::Gemm g{(const bf16_t*)(ws + OFF_H), (const bf16_t*)(ws + OFF_WRG), TTOK, 4096, 2048};
        S.init(g.M, g.N, gridDim.x, bidx()); EpiRetGate E{(bf16_t*)(ws + OFF_RO), (const float*)(ws + OFF_SSQ)};
        pg8::gemm_phase<EpiRetGate, pg8::StaticOrder>(L, g, S, E); }
}
#ifndef ONE_LAUNCH
#define ONE_LAUNCH 1
#endif
#if ONE_LAUNCH
DI void grid_barrier(unsigned* ctr, unsigned target) {
    asm volatile("s_waitcnt vmcnt(0)" ::: "memory");
    __syncthreads();
    if (threadIdx.x == 0) {
        __builtin_amdgcn_fence(__ATOMIC_RELEASE, "agent");
        asm volatile("s_waitcnt vmcnt(0)" ::: "memory");
        __hip_atomic_fetch_add(ctr, 1u, __ATOMIC_RELAXED, __HIP_MEMORY_SCOPE_AGENT);
        while (__hip_atomic_load(ctr, __ATOMIC_RELAXED, __HIP_MEMORY_SCOPE_AGENT) < target) __builtin_amdgcn_s_sleep(1);
        __builtin_amdgcn_fence(__ATOMIC_ACQUIRE, "agent");
        asm volatile("s_waitcnt vmcnt(0)" ::: "memory");
    }
    __syncthreads();
}
__global__ void __launch_bounds__(NTHREADS, 2) mega_fwd(Params Pin, int ph_lo, int ph_hi) {
    extern __shared__ __attribute__((aligned(16))) unsigned char shm[];
    LAS unsigned char* L = (LAS unsigned char*)shm;
    cg::grid_group grid = cg::this_grid();
    unsigned nbar = 0;
    for (int ph = ph_lo; ph < ph_hi; ++ph) {
        typedef const Params __attribute__((address_space(4))) * KP;
        KP pk = (KP)__builtin_amdgcn_kernarg_segment_ptr();
        asm volatile("" : "+s"(pk));
        Params P;
        P.x = pk->x; P.c = pk->c; P.w_mod = pk->w_mod; P.b_mod = pk->b_mod; P.norm_mix = pk->norm_mix; P.norm_ffn = pk->norm_ffn; P.rel_bias = pk->rel_bias;
        P.att_w_qkv = pk->att_w_qkv; P.att_q_gain = pk->att_q_gain; P.att_k_gain = pk->att_k_gain; P.att_w_o = pk->att_w_o; P.ret_w_qkvg = pk->ret_w_qkvg; P.ret_w_o = pk->ret_w_o;
        P.ffn_w_up = pk->ffn_w_up; P.ffn_w_down = pk->ffn_w_down; P.out = pk->out; P.ws = pk->ws;
        int type, a0, a1, a2; decode_phase(ph, type, a0, a1, a2);
        switch (type) {
            case 0: run_phase<0>(P, a0, a1, a2, L); break; case 1: run_phase<1>(P, a0, a1, a2, L); break;
            case 2: run_phase<2>(P, a0, a1, a2, L); break; case 3: run_phase<3>(P, a0, a1, a2, L); break;
            case 4: run_phase<4>(P, a0, a1, a2, L); break; case 5: run_phase<5>(P, a0, a1, a2, L); break;
            case 6: run_phase<6>(P, a0, a1, a2, L); break; case 7: run_phase<7>(P, a0, a1, a2, L); break;
            case 8: run_phase<8>(P, a0, a1, a2, L); break; default: run_phase<9>(P, a0, a1, a2, L); break;
        }
        if (ph + 1 < ph_hi) {
            unsigned* ctr = (unsigned*)(P.ws + OFF_BAR);
            if (ph == ph_lo) { if (blockIdx.x == 0 && threadIdx.x == 0) __hip_atomic_store(ctr, 0u, __ATOMIC_RELAXED, __HIP_MEMORY_SCOPE_AGENT); grid.sync(); }
            else { ++nbar; grid_barrier(ctr, nbar * gridDim.x); }
        }
    }
}
#endif
extern "C" void kernel_launch(void* const* d_in, const int* in_sizes, int n_in, void* d_out, int out_size, void* d_ws, size_t ws_size, hipStream_t stream) {
    static int grid = 0;
    if (grid == 0) {
        int dev = 0, cus = 0;
        (void)hipGetDevice(&dev);
        (void)hipDeviceGetAttribute(&cus, hipDeviceAttributeMultiprocessorCount, dev);
        grid = cus > 0 ? cus : 256;
        if (ws_size < WS_NEED) fprintf(stderr, "kernel_launch: workspace too small: %zu < %zu\n", ws_size, (size_t)WS_NEED);
    }
    Params p{};
    p.x = (const float*)d_in[0]; p.c = (const float*)d_in[1]; p.w_mod = (const float*)d_in[2]; p.b_mod = (const float*)d_in[3]; p.norm_mix = (const float*)d_in[4]; p.norm_ffn = (const float*)d_in[5];
    p.rel_bias = (const float*)d_in[6]; p.att_w_qkv = (const float*)d_in[7]; p.att_q_gain = (const float*)d_in[8]; p.att_k_gain = (const float*)d_in[9]; p.att_w_o = (const float*)d_in[10];
    p.ret_w_qkvg = (const float*)d_in[11]; p.ret_w_o = (const float*)d_in[12]; p.ffn_w_up = (const float*)d_in[13]; p.ffn_w_down = (const float*)d_in[14];
    p.out = (float*)d_out; p.ws = (unsigned char*)d_ws;
#if ONE_LAUNCH
    static bool attr = false;
    if (!attr) { (void)hipFuncSetAttribute((const void*)mega_fwd, hipFuncAttributeMaxDynamicSharedMemorySize, LDS_BYTES); attr = true; }
    int lo = 0, hi = NPH;
    void* args[] = {&p, &lo, &hi};
    hipError_t e = hipLaunchCooperativeKernel((const void*)mega_fwd, dim3(grid), dim3(NTHREADS), args, LDS_BYTES, stream);
    if (e != hipSuccess) fprintf(stderr, "kernel_launch: cooperative launch failed: %s (grid %d)\n", hipGetErrorString(e), grid);
#endif
}
```

```cpp
#include <hip/hip_runtime.h>
#include <hip/hip_cooperative_groups.h>
#include <cstdio>
namespace cg = cooperative_groups;

#define LAS __attribute__((address_space(3)))
#define PG8_LAS LAS
typedef unsigned short bf16_t;
typedef short bf16x8 __attribute__((ext_vector_type(8)));
typedef float f32x4 __attribute__((ext_vector_type(4)));
typedef unsigned u32x4 __attribute__((ext_vector_type(4)));
typedef unsigned u32x2 __attribute__((ext_vector_type(2)));
#define DI __device__ __forceinline__

constexpr int TTOK = 32768, DM = 2048, SEQL = 4096, DFF = 5632, MODW = 12288;
constexpr float LOG2E = 1.4426950408889634f;
constexpr float NEPS = 1e-6f;
constexpr int LDS_BYTES = 163840;
constexpr int NTHREADS = 512;

constexpr size_t MB = 1048576;
constexpr size_t OFF_MOD = 0;
constexpr size_t OFF_COS = 1 * MB;
constexpr size_t OFF_SIN = 3 * MB;
constexpr size_t OFF_LSE = 5 * MB;
constexpr size_t OFF_SSQ = 8 * MB;
constexpr size_t OFF_BAR = 12 * MB;
constexpr size_t OFF_H   = 16 * MB;
constexpr size_t OFF_W   = 144 * MB;
constexpr size_t OFF_WQKV0 = OFF_W;
constexpr size_t OFF_WO0   = OFF_WQKV0 + 72 * MB;
constexpr size_t OFF_WUP0  = OFF_WO0 + 8 * MB;
constexpr size_t OFF_WDN0  = OFF_WUP0 + 44 * MB;
constexpr size_t OFF_BIG0  = OFF_WDN0 + 22 * MB;
constexpr size_t OFF_QKVC  = OFF_BIG0;
constexpr size_t OFF_OG    = OFF_QKVC + 288 * MB;
constexpr size_t OFF_O     = OFF_OG + 96 * MB;
constexpr size_t OFF_HID0  = OFF_BIG0;
constexpr size_t OFF_XB1   = 802 * MB;
constexpr size_t OFF_WRQKV = OFF_W;
constexpr size_t OFF_WRG   = OFF_WRQKV + 32 * MB;
constexpr size_t OFF_WRO   = OFF_WRG + 16 * MB;
constexpr size_t OFF_BIG1  = OFF_WRO + 16 * MB;
constexpr size_t OFF_RQ    = OFF_BIG1;
constexpr size_t OFF_RK    = OFF_RQ + 128 * MB;
constexpr size_t OFF_RV    = OFF_RK + 128 * MB;
constexpr size_t OFF_RO    = OFF_RV + 256 * MB;
constexpr size_t OFF_WUP1  = OFF_BIG1;
constexpr size_t OFF_WDN1  = OFF_WUP1 + 44 * MB;
constexpr size_t OFF_XB3   = 464 * MB;
constexpr size_t OFF_HID1  = 592 * MB;
constexpr size_t WS_NEED   = OFF_RO + 256 * MB;

struct Params {
    const float *x, *c, *w_mod, *b_mod, *norm_mix, *norm_ffn, *rel_bias, *att_w_qkv, *att_q_gain, *att_k_gain, *att_w_o, *ret_w_qkvg, *ret_w_o, *ffn_w_up, *ffn_w_down;
    float* out; unsigned char* ws;
};

DI unsigned cvt_pk_bf16(float lo, float hi) { unsigned r; asm volatile("v_cvt_pk_bf16_f32 %0, %1, %2" : "=v"(r) : "v"(lo), "v"(hi)); return r; }
DI float bf_lo(unsigned u) { return __uint_as_float(u << 16); }
DI float bf_hi(unsigned u) { return __uint_as_float(u & 0xffff0000u); }
DI float silu_f(float v) { return v * __builtin_amdgcn_rcpf(1.0f + __expf(-v)); }
DI float shx(float v, int m) { return __shfl_xor(v, m); }
DI int tidx() { int t = threadIdx.x; asm volatile("" : "+v"(t)); return t; }
DI int bidx() { int b = blockIdx.x; asm volatile("" : "+s"(b)); return b; }

namespace pg8 {
constexpr int BM = 256, BK = 64, HALF = 128, HTB = HALF * BK * 2, STAGE_BYTES = 8 * HTB, NXCD = 8, WGM = 8;
__host__ __device__ __forceinline__ int lds_byte(int r, int c) { const int st = (r >> 4) * 2 + (c >> 5), rr = r & 15, cc = c & 31, ob = rr * 64 + cc * 2; return st * 1024 + (ob ^ (((ob >> 9) & 1) << 5)); }
__host__ __device__ __forceinline__ void stage_rc(int b, int& R, int& C) { const int st = b / 1024, sb = b % 1024, swz = sb ^ (((sb >> 9) & 1) << 5); R = (st >> 1) * 16 + swz / 64; C = (st & 1) * 32 + (swz % 64) / 2; }
__host__ __device__ __forceinline__ int perm32(int rho) { const int n = rho >> 4, i = rho & 15; return 8 * (i >> 2) + 4 * n + (i & 3); }
struct Unit { int pm, pn; };
struct Gemm { const bf16_t* A; const bf16_t* Bt; int M, N, K; };
struct StaticOrder {
    int nM, nN, nwg, G, c, wgm;
    __device__ void init(int M, int N, int G_, int c_, int wgm_ = WGM) { nM = M / BM; nN = N / BM; nwg = nM * nN; G = G_; c = c_; wgm = wgm_; }
    __device__ bool next(int i, Unit& u) const {
        const long L = (long)i * G + c; if (L >= nwg) return false;
        int wgid = (int)L; { const int q = nwg / NXCD, r = nwg % NXCD, xcd = wgid % NXCD, off = wgid / NXCD; wgid = (xcd < r ? xcd * (q + 1) : r * (q + 1) + (xcd - r) * q) + off; }
        const int nig = wgm * nN, gid = wgid / nig, fm = gid * wgm, gsz = (nM - fm) < wgm ? (nM - fm) : wgm;
        u.pm = fm + ((wgid % nig) % gsz); u.pn = (wgid % nig) / gsz; return true;
    }
    __device__ __forceinline__ void a_ready(const Unit&) const {}
    __device__ __forceinline__ void done(const Unit&) const {}
};
template <class Epi, class Sched>
__device__ __forceinline__ void gemm_phase(PG8_LAS unsigned char* lds, const Gemm g, const Sched& S, const Epi& E) {
    const int tid = tidx(), wid = __builtin_amdgcn_readfirstlane(tid >> 6), lane = tid & 63, wr = wid >> 2, wc = wid & 3, fr = lane & 15, fq = lane >> 4;
    const int K = g.K, nt = K / BK;
    unsigned voffA[2], voffB[2];
#pragma unroll
    for (int i = 0; i < 2; ++i) { int R, C; stage_rc(tid * 16 + i * 8192, R, C); const int Rb = Epi::PERM ? ((R & ~31) + perm32(R & 31)) : R;
        voffA[i] = (unsigned)(R * K + C) * 2u; voffB[i] = (unsigned)(Rb * K + C) * 2u; }
    const size_t kstep = (size_t)(BK * 2);
    const size_t hstep = (size_t)HALF * K * 2;
    const size_t tstep = 2 * hstep;
    const unsigned ldsw = (unsigned)wid * 1024u;
    const int aoff = lds_byte(wr * 64 + fr, fq * 8), boff = lds_byte(wc * 32 + fr, fq * 8);
#define PG8_SA(b, h) (((b) * 2 + (h)) * HTB)
#define PG8_SB(b, h) ((4 + (b) * 2 + (h)) * HTB)
#define PG8_STAGE(bufoff, gbase, voff) do { _Pragma("unroll") for (int _i = 0; _i < 2; ++_i) \
        __builtin_amdgcn_global_load_lds((const unsigned*)((const char*)(gbase) + (voff)[_i]), (PG8_LAS unsigned*)(lds + (bufoff) + ldsw + _i * 8192), 16, 0, 0); } while (0)
#define PG8_LDA(dst, b, h) do { _Pragma("unroll") for (int m = 0; m < 4; ++m) _Pragma("unroll") for (int k = 0; k < 2; ++k) dst[m][k] = *(const PG8_LAS bf16x8*)(lds + PG8_SA(b, h) + aoff + m * 2048 + k * 1024); } while (0)
#define PG8_LDB(dst, b, h) do { _Pragma("unroll") for (int n = 0; n < 2; ++n) _Pragma("unroll") for (int k = 0; k < 2; ++k) dst[n][k] = *(const PG8_LAS bf16x8*)(lds + PG8_SB(b, h) + boff + n * 2048 + k * 1024); } while (0)
#define PG8_MMA(ai, bj, At, Bt) do { __builtin_amdgcn_s_setprio(1); _Pragma("unroll") for (int m = 0; m < 4; ++m) _Pragma("unroll") for (int n = 0; n < 2; ++n) _Pragma("unroll") for (int k = 0; k < 2; ++k) \
        acc[ai][bj][m][n] = __builtin_amdgcn_mfma_f32_16x16x32_bf16(Bt[n][k], At[m][k], acc[ai][bj][m][n], 0, 0, 0); __builtin_amdgcn_s_setprio(0); } while (0)
#define PG8_WAIT_V(n) asm volatile("s_waitcnt vmcnt(" #n ")" ::: "memory")
#define PG8_WAIT_L(n) asm volatile("s_waitcnt lgkmcnt(" #n ")" ::: "memory")
#define PG8_BAR __builtin_amdgcn_s_barrier()
#define PG8_SCHED __builtin_amdgcn_sched_barrier(0)
    Unit cur, nxt; int ui = 0;
    if (!S.next(0, cur)) return;
    f32x4 acc[2][2][4][2];
#pragma unroll
    for (int a = 0; a < 2; ++a)
#pragma unroll
        for (int b = 0; b < 2; ++b)
#pragma unroll
            for (int m = 0; m < 4; ++m)
#pragma unroll
                for (int n = 0; n < 2; ++n) acc[a][b][m][n] = (f32x4){0.f, 0.f, 0.f, 0.f};
    bf16x8 At[4][2], B0[2][2], B1[2][2];
    const char* cA = (const char*)g.A + (size_t)cur.pm * tstep; const char* cB = (const char*)g.Bt + (size_t)cur.pn * tstep;
    S.a_ready(cur);
    PG8_STAGE(PG8_SB(0, 0), cB, voffB); PG8_STAGE(PG8_SA(0, 0), cA, voffA); PG8_STAGE(PG8_SB(0, 1), cB + hstep, voffB); PG8_STAGE(PG8_SA(0, 1), cA + hstep, voffA);
    if (wr == 1) PG8_BAR;
    PG8_WAIT_V(4); PG8_BAR;
    PG8_STAGE(PG8_SB(1, 0), cB + kstep, voffB); PG8_STAGE(PG8_SA(1, 0), cA + kstep, voffA); PG8_STAGE(PG8_SB(1, 1), cB + hstep + kstep, voffB);
    PG8_WAIT_V(6); PG8_BAR;
    for (;;) {
        const bool has_next = S.next(ui + 1, nxt);
        const char* nA = has_next ? (const char*)g.A + (size_t)nxt.pm * tstep : cA; const char* nB = has_next ? (const char*)g.Bt + (size_t)nxt.pn * tstep : cB;
        for (int t = 0; t < nt; t += 2) {
            const bool last = (t == nt - 2);
            const char* a1 = cA + (size_t)(t + 1) * kstep;
            const char* a2 = last ? nA : cA + (size_t)(t + 2) * kstep; const char* b2 = last ? nB : cB + (size_t)(t + 2) * kstep;
            const char* a3 = a2 + kstep; const char* b3 = b2 + kstep;
            if (last && has_next) S.a_ready(nxt);
            PG8_LDB(B0, 0, 0); PG8_SCHED; PG8_LDA(At, 0, 0); PG8_STAGE(PG8_SA(1, 1), a1 + hstep, voffA);
            PG8_WAIT_L(8); PG8_BAR; PG8_WAIT_L(0); PG8_MMA(0, 0, At, B0); PG8_BAR; PG8_SCHED;
            PG8_LDB(B1, 0, 1); PG8_STAGE(PG8_SB(0, 0), b2, voffB);
            PG8_BAR; PG8_WAIT_L(0); PG8_MMA(0, 1, At, B1); PG8_BAR;
            PG8_LDA(At, 0, 1); PG8_STAGE(PG8_SA(0, 0), a2, voffA);
            PG8_BAR; PG8_WAIT_L(0); PG8_MMA(1, 0, At, B0); PG8_BAR; PG8_SCHED;
            PG8_STAGE(PG8_SB(0, 1), b2 + hstep, voffB);
            PG8_WAIT_V(6); PG8_BAR; PG8_MMA(1, 1, At, B1); PG8_BAR;
            PG8_LDB(B0, 1, 0); PG8_SCHED; PG8_LDA(At, 1, 0); PG8_STAGE(PG8_SA(0, 1), a2 + hstep, voffA);
            PG8_WAIT_L(8); PG8_BAR; PG8_WAIT_L(0); PG8_MMA(0, 0, At, B0); PG8_BAR; PG8_SCHED;
            PG8_LDB(B1, 1, 1); PG8_STAGE(PG8_SB(1, 0), b3, voffB);
            PG8_BAR; PG8_WAIT_L(0); PG8_MMA(0, 1, At, B1); PG8_BAR;
            PG8_LDA(At, 1, 1); PG8_STAGE(PG8_SA(1, 0), a3, voffA);
            PG8_BAR; PG8_WAIT_L(0); PG8_MMA(1, 0, At, B0); PG8_BAR; PG8_SCHED;
            PG8_STAGE(PG8_SB(1, 1), b3 + hstep, voffB);
            PG8_WAIT_V(6); PG8_BAR; PG8_MMA(1, 1, At, B1); PG8_BAR;
        }
        E(acc, cur, wr, wc, fr, fq); S.done(cur);
        if (!has_next) break;
#pragma unroll
        for (int a = 0; a < 2; ++a)
#pragma unroll
            for (int b = 0; b < 2; ++b)
#pragma unroll
                for (int m = 0; m < 4; ++m)
#pragma unroll
                    for (int n = 0; n < 2; ++n) acc[a][b][m][n] = (f32x4){0.f, 0.f, 0.f, 0.f};
        cur = nxt; cA = nA; cB = nB; ++ui;
    }
    PG8_WAIT_V(0);
    if (wr == 0) PG8_BAR;
    PG8_BAR;
#undef PG8_SA
#undef PG8_SB
#undef PG8_STAGE
#undef PG8_LDA
#undef PG8_LDB
#undef PG8_MMA
#undef PG8_WAIT_V
#undef PG8_WAIT_L
#undef PG8_BAR
#undef PG8_SCHED
}
}
using pg8::Unit;
typedef f32x4 AccT[2][2][4][2];

struct EpiPlainBf16 {
    static constexpr bool PERM = true;
    bf16_t* O; int ldc;
    DI void operator()(const AccT& acc, const Unit& u, int wr, int wc, int fr, int fq) const {
        const int row0 = u.pm * 256 + wr * 64 + fr, col0 = u.pn * 256 + wc * 32 + 8 * fq;
#pragma unroll
        for (int ai = 0; ai < 2; ++ai)
#pragma unroll
            for (int m = 0; m < 4; ++m) { bf16_t* rowp = O + (size_t)(row0 + ai * 128 + m * 16) * ldc + col0;
#pragma unroll
                for (int bj = 0; bj < 2; ++bj) { const f32x4 v0 = acc[ai][bj][m][0], v1 = acc[ai][bj][m][1];
                    u32x4 w; w.x = cvt_pk_bf16(v0[0], v0[1]); w.y = cvt_pk_bf16(v0[2], v0[3]); w.z = cvt_pk_bf16(v1[0], v1[1]); w.w = cvt_pk_bf16(v1[2], v1[3]);
                    *(u32x4*)(rowp + bj * 128) = w; } }
    }
};
struct EpiResid {
    static constexpr bool PERM = false;
    const float* R; float* O; const float* gate;
    DI void operator()(const AccT& acc, const Unit& u, int wr, int wc, int fr, int fq) const {
        const int row0 = u.pm * 256 + wr * 64 + fr, col0 = u.pn * 256 + wc * 32 + 4 * fq;
        const int b = (u.pm * 256) >> 12;
        f32x4 gv[2][2];
#pragma unroll
        for (int bj = 0; bj < 2; ++bj)
#pragma unroll
            for (int n = 0; n < 2; ++n) gv[bj][n] = *(const f32x4*)(gate + (size_t)b * MODW + col0 + bj * 128 + n * 16);
#pragma unroll
        for (int ai = 0; ai < 2; ++ai)
#pragma unroll
            for (int mp = 0; mp < 2; ++mp) {
                f32x4 rv[2][2][2];
#pragma unroll
                for (int mm = 0; mm < 2; ++mm) { const size_t ro = (size_t)(row0 + ai * 128 + (2 * mp + mm) * 16) * DM + col0;
#pragma unroll
                    for (int bj = 0; bj < 2; ++bj)
#pragma unroll
                        for (int n = 0; n < 2; ++n) rv[mm][bj][n] = *(const f32x4*)(R + ro + bj * 128 + n * 16); }
#pragma unroll
                for (int mm = 0; mm < 2; ++mm) { const size_t ro = (size_t)(row0 + ai * 128 + (2 * mp + mm) * 16) * DM + col0;
#pragma unroll
                    for (int bj = 0; bj < 2; ++bj)
#pragma unroll
                        for (int n = 0; n < 2; ++n) *(f32x4*)(O + ro + bj * 128 + n * 16) = rv[mm][bj][n] + gv[bj][n] * acc[ai][bj][2 * mp + mm][n]; }
            }
    }
};
struct EpiResidF2B {
    static constexpr bool PERM = true;
    const float* R; bf16_t* O; const float* gate;
    DI void operator()(const AccT& acc, const Unit& u, int wr, int wc, int fr, int fq) const {
        const int row0 = u.pm * 256 + wr * 64 + fr, col0 = u.pn * 256 + wc * 32 + 8 * fq;
        const int b = (u.pm * 256) >> 12;
        f32x4 gv[2][2];
#pragma unroll
        for (int bj = 0; bj < 2; ++bj)
#pragma unroll
            for (int n = 0; n < 2; ++n) gv[bj][n] = *(const f32x4*)(gate + (size_t)b * MODW + col0 + bj * 128 + n * 4);
#pragma unroll
        for (int ai = 0; ai < 2; ++ai)
#pragma unroll
            for (int mp = 0; mp < 2; ++mp) {
                f32x4 rv[2][2][2];
#pragma unroll
                for (int mm = 0; mm < 2; ++mm) { const size_t ro = (size_t)(row0 + ai * 128 + (2 * mp + mm) * 16) * DM + col0;
#pragma unroll
                    for (int bj = 0; bj < 2; ++bj)
#pragma unroll
                        for (int n = 0; n < 2; ++n) rv[mm][bj][n] = *(const f32x4*)(R + ro + bj * 128 + n * 4); }
#pragma unroll
                for (int mm = 0; mm < 2; ++mm) { const size_t ro = (size_t)(row0 + ai * 128 + (2 * mp + mm) * 16) * DM + col0;
#pragma unroll
                    for (int bj = 0; bj < 2; ++bj) { const f32x4 v0 = rv[mm][bj][0] + gv[bj][0] * acc[ai][bj][2 * mp + mm][0], v1 = rv[mm][bj][1] + gv[bj][1] * acc[ai][bj][2 * mp + mm][1];
                        u32x4 w; w.x = cvt_pk_bf16(v0[0], v0[1]); w.y = cvt_pk_bf16(v0[2], v0[3]); w.z = cvt_pk_bf16(v1[0], v1[1]); w.w = cvt_pk_bf16(v1[2], v1[3]);
                        *(u32x4*)(O + ro + bj * 128) = w; } }
            }
    }
};
struct EpiResidB2F {
    static constexpr bool PERM = true;
    const bf16_t* R; float* O; const float* gate;
    DI void operator()(const AccT& acc, const Unit& u, int wr, int wc, int fr, int fq) const {
        const int row0 = u.pm * 256 + wr * 64 + fr, col0 = u.pn * 256 + wc * 32 + 8 * fq;
        const int b = (u.pm * 256) >> 12;
        f32x4 gv[2][2];
#pragma unroll
        for (int bj = 0; bj < 2; ++bj)
#pragma unroll
            for (int n = 0; n < 2; ++n) gv[bj][n] = *(const f32x4*)(gate + (size_t)b * MODW + col0 + bj * 128 + n * 4);
#pragma unroll
        for (int ai = 0; ai < 2; ++ai) {
            u32x4 rb[4][2];
#pragma unroll
            for (int m = 0; m < 4; ++m) { const size_t ro = (size_t)(row0 + ai * 128 + m * 16) * DM + col0;
#pragma unroll
                for (int bj = 0; bj < 2; ++bj) rb[m][bj] = *(const u32x4*)(R + ro + bj * 128); }
#pragma unroll
            for (int m = 0; m < 4; ++m) { const size_t ro = (size_t)(row0 + ai * 128 + m * 16) * DM + col0;
#pragma unroll
                for (int bj = 0; bj < 2; ++bj) { const u32x4 t = rb[m][bj];
                    const f32x4 r0 = (f32x4){bf_lo(t.x), bf_hi(t.x), bf_lo(t.y), bf_hi(t.y)}, r1 = (f32x4){bf_lo(t.z), bf_hi(t.z), bf_lo(t.w), bf_hi(t.w)};
                    *(f32x4*)(O + ro + bj * 128) = r0 + gv[bj][0] * acc[ai][bj][m][0];
                    *(f32x4*)(O + ro + bj * 128 + 4) = r1 + gv[bj][1] * acc[ai][bj][m][1]; } }
        }
    }
};
struct EpiResidB2B {
    static constexpr bool PERM = true;
    const bf16_t* R; bf16_t* O; const float* gate;
    DI void operator()(const AccT& acc, const Unit& u, int wr, int wc, int fr, int fq) const {
        const int row0 = u.pm * 256 + wr * 64 + fr, col0 = u.pn * 256 + wc * 32 + 8 * fq;
        const int b = (u.pm * 256) >> 12;
        f32x4 gv[2][2];
#pragma unroll
        for (int bj = 0; bj < 2; ++bj)
#pragma unroll
            for (int n = 0; n < 2; ++n) gv[bj][n] = *(const f32x4*)(gate + (size_t)b * MODW + col0 + bj * 128 + n * 4);
#pragma unroll
        for (int ai = 0; ai < 2; ++ai) {
            u32x4 rb[4][2];
#pragma unroll
            for (int m = 0; m < 4; ++m) { const size_t ro = (size_t)(row0 + ai * 128 + m * 16) * DM + col0;
#pragma unroll
                for (int bj = 0; bj < 2; ++bj) rb[m][bj] = *(const u32x4*)(R + ro + bj * 128); }
#pragma unroll
            for (int m = 0; m < 4; ++m) { const size_t ro = (size_t)(row0 + ai * 128 + m * 16) * DM + col0;
#pragma unroll
                for (int bj = 0; bj < 2; ++bj) { const u32x4 t = rb[m][bj];
                    const f32x4 r0 = (f32x4){bf_lo(t.x), bf_hi(t.x), bf_lo(t.y), bf_hi(t.y)}, r1 = (f32x4){bf_lo(t.z), bf_hi(t.z), bf_lo(t.w), bf_hi(t.w)};
                    const f32x4 v0 = r0 + gv[bj][0] * acc[ai][bj][m][0], v1 = r1 + gv[bj][1] * acc[ai][bj][m][1];
                    u32x4 w; w.x = cvt_pk_bf16(v0[0], v0[1]); w.y = cvt_pk_bf16(v0[2], v0[3]); w.z = cvt_pk_bf16(v1[0], v1[1]); w.w = cvt_pk_bf16(v1[2], v1[3]);
                    *(u32x4*)(O + ro + bj * 128) = w; } }
        }
    }
};
struct EpiSwiGLU {
    static constexpr bool PERM = true;
    bf16_t* O;
    DI void operator()(const AccT& acc, const Unit& u, int wr, int wc, int fr, int fq) const {
        const int row0 = u.pm * 256 + wr * 64 + fr, col0 = u.pn * 128 + wc * 32 + 8 * fq;
#pragma unroll
        for (int ai = 0; ai < 2; ++ai)
#pragma unroll
            for (int m = 0; m < 4; ++m) { bf16_t* rowp = O + (size_t)(row0 + ai * 128 + m * 16) * DFF + col0;
                float r[8];
#pragma unroll
                for (int n = 0; n < 2; ++n)
#pragma unroll
                    for (int e = 0; e < 4; ++e) r[n * 4 + e] = silu_f(acc[ai][0][m][n][e]) * acc[ai][1][m][n][e];
                u32x4 w; w.x = cvt_pk_bf16(r[0], r[1]); w.y = cvt_pk_bf16(r[2], r[3]); w.z = cvt_pk_bf16(r[4], r[5]); w.w = cvt_pk_bf16(r[6], r[7]);
                *(u32x4*)rowp = w; }
    }
};
struct EpiRetQKV {
    static constexpr bool PERM = true;
    bf16_t *Q, *Kt, *V; const float *cosT, *sinT;
    DI void operator()(const AccT& acc, const Unit& u, int wr, int wc, int fr, int fq) const {
        const int row0 = u.pm * 256 + wr * 64 + fr, i0 = wc * 32 + 8 * fq;
        if (u.pn >= 16) {
#pragma unroll
            for (int ai = 0; ai < 2; ++ai)
#pragma unroll
                for (int m = 0; m < 4; ++m) { bf16_t* rowp = V + (size_t)(row0 + ai * 128 + m * 16) * 4096 + (u.pn - 16) * 256 + i0;
#pragma unroll
                    for (int bj = 0; bj < 2; ++bj) { const f32x4 v0 = acc[ai][bj][m][0], v1 = acc[ai][bj][m][1];
                        u32x4 w; w.x = cvt_pk_bf16(v0[0], v0[1]); w.y = cvt_pk_bf16(v0[2], v0[3]); w.z = cvt_pk_bf16(v1[0], v1[1]); w.w = cvt_pk_bf16(v1[2], v1[3]);
                        *(u32x4*)(rowp + bj * 128) = w; } }
            return;
        }
        const bool isk = u.pn >= 8; const int hd = u.pn & 7;
        bf16_t* dst = (isk ? Kt : Q) + hd * 256 + i0;
        const float l2g = __log2f(1.0f - exp2f(-5.0f - (float)hd));
#pragma unroll
        for (int ai = 0; ai < 2; ++ai) {
            f32x4 cvs[4][2], svs[4][2];
#pragma unroll
            for (int m = 0; m < 4; ++m) { const int s = (row0 + ai * 128 + m * 16) & 4095;
#pragma unroll
                for (int n = 0; n < 2; ++n) { cvs[m][n] = *(const f32x4*)(cosT + s * 128 + i0 + n * 4); svs[m][n] = *(const f32x4*)(sinT + s * 128 + i0 + n * 4); } }
#pragma unroll
            for (int m = 0; m < 4; ++m) { const int row = row0 + ai * 128 + m * 16; const int s = row & 4095;
                const float sc = isk ? 0.0625f * exp2f(-(float)((s & 127) + 1) * l2g) : 1.0f;
                float o1[8], o2[8];
#pragma unroll
                for (int n = 0; n < 2; ++n) { const f32x4 cv = cvs[m][n], sv = svs[m][n];
                    const f32x4 t1 = acc[ai][0][m][n], t2 = acc[ai][1][m][n];
#pragma unroll
                    for (int e = 0; e < 4; ++e) { o1[n * 4 + e] = (t1[e] * cv[e] - t2[e] * sv[e]) * sc; o2[n * 4 + e] = (t1[e] * sv[e] + t2[e] * cv[e]) * sc; } }
                u32x4 w1, w2;
                w1.x = cvt_pk_bf16(o1[0], o1[1]); w1.y = cvt_pk_bf16(o1[2], o1[3]); w1.z = cvt_pk_bf16(o1[4], o1[5]); w1.w = cvt_pk_bf16(o1[6], o1[7]);
                w2.x = cvt_pk_bf16(o2[0], o2[1]); w2.y = cvt_pk_bf16(o2[2], o2[3]); w2.z = cvt_pk_bf16(o2[4], o2[5]); w2.w = cvt_pk_bf16(o2[6], o2[7]);
                bf16_t* rp = dst + (size_t)row * 2048;
                *(u32x4*)rp = w1; *(u32x4*)(rp + 128) = w2; }
        }
    }
};
struct EpiRetGate {
    static constexpr bool PERM = true;
    bf16_t* RO; const float* ssq;
    DI void operator()(const AccT& acc, const Unit& u, int wr, int wc, int fr, int fq) const {
        const int row0 = u.pm * 256 + wr * 64 + fr, col0 = u.pn * 256 + wc * 32 + 8 * fq, hd = u.pn >> 1;
#pragma unroll
        for (int ai = 0; ai < 2; ++ai) {
            f32x4 sq[4]; u32x4 ov[4][2];
#pragma unroll
            for (int m = 0; m < 4; ++m) { const int row = row0 + ai * 128 + m * 16; sq[m] = *(const f32x4*)(ssq + (size_t)row * 32 + hd * 4);
                const bf16_t* rowp = RO + (size_t)row * 4096 + col0; ov[m][0] = *(const u32x4*)rowp; ov[m][1] = *(const u32x4*)(rowp + 128); }
#pragma unroll
            for (int m = 0; m < 4; ++m) { const int row = row0 + ai * 128 + m * 16;
                const float rn = rsqrtf((sq[m][0] + sq[m][1] + sq[m][2] + sq[m][3]) * (1.0f / 512.0f) + NEPS);
                bf16_t* rowp = RO + (size_t)row * 4096 + col0;
#pragma unroll
                for (int bj = 0; bj < 2; ++bj) { const u32x4 o = ov[m][bj];
                    const f32x4 g0 = acc[ai][bj][m][0], g1 = acc[ai][bj][m][1];
                    u32x4 w;
                    w.x = cvt_pk_bf16(silu_f(g0[0]) * bf_lo(o.x) * rn, silu_f(g0[1]) * bf_hi(o.x) * rn);
                    w.y = cvt_pk_bf16(silu_f(g0[2]) * bf_lo(o.y) * rn, silu_f(g0[3]) * bf_hi(o.y) * rn);
                    w.z = cvt_pk_bf16(silu_f(g1[0]) * bf_lo(o.z) * rn, silu_f(g1[1]) * bf_hi(o.z) * rn);
                    w.w = cvt_pk_bf16(silu_f(g1[2]) * bf_lo(o.w) * rn, silu_f(g1[3]) * bf_hi(o.w) * rn);
                    *(u32x4*)(rowp + bj * 128) = w; } }
        }
    }
};

struct CJob { const float* src; bf16_t* dst; int ldsrc, K, nrows, mode, coff; };
DI void convert_w(const CJob j, LAS unsigned* lw) {
    const int tid = tidx(), ntR = j.nrows >> 6, ntK = j.K >> 7, total = ntR * ntK;
    const int nq = tid & 15, kr = tid >> 4;
    auto tile_src = [&](int tile) -> const float* { const int rt = tile % ntR, kt = tile / ntR, R0 = rt * 64, k0 = kt * 128;
        const int c0 = j.mode == 0 ? j.coff + R0 : ((R0 >> 7) & 1) * DFF + (R0 >> 8) * 128 + (R0 & 127);
        return j.src + (size_t)(k0 + 2 * kr) * j.ldsrc + c0 + 4 * nq; };
    f32x4 a[2][2], an[2][2];
    int tile = bidx();
    if (tile < total) { const float* sp = tile_src(tile);
#pragma unroll
        for (int p = 0; p < 2; ++p) { const float* s = sp + (size_t)(64 * p) * j.ldsrc; a[p][0] = *(const f32x4*)s; a[p][1] = *(const f32x4*)(s + j.ldsrc); } }
    for (; tile < total; tile += gridDim.x) {
        const int rt = tile % ntR, kt = tile / ntR, R0 = rt * 64, k0 = kt * 128;
        { const int tnext = tile + gridDim.x; const float* sp = tile_src(tnext < total ? tnext : tile);
#pragma unroll
            for (int p = 0; p < 2; ++p) { const float* s = sp + (size_t)(64 * p) * j.ldsrc; an[p][0] = *(const f32x4*)s; an[p][1] = *(const f32x4*)(s + j.ldsrc); } }
#pragma unroll
        for (int p = 0; p < 2; ++p) { const int kp = p * 32 + kr;
#pragma unroll
            for (int e = 0; e < 4; ++e) lw[(4 * nq + e) * 65 + kp] = cvt_pk_bf16(a[p][0][e], a[p][1][e]); }
        __syncthreads();
#pragma unroll
        for (int i = 0; i < 2; ++i) { const int idx = tid + 512 * i, n = idx >> 4, ch = idx & 15;
            u32x4 v; v.x = lw[n * 65 + 4 * ch]; v.y = lw[n * 65 + 4 * ch + 1]; v.z = lw[n * 65 + 4 * ch + 2]; v.w = lw[n * 65 + 4 * ch + 3];
            *(u32x4*)(j.dst + (size_t)(R0 + n) * j.K + k0 + 8 * ch) = v; }
        __syncthreads();
#pragma unroll
        for (int p = 0; p < 2; ++p) { a[p][0] = an[p][0]; a[p][1] = an[p][1]; }
    }
}
DI void convert_set(const Params& P, int set, LAS unsigned* lw) {
    const int njobs = set == 0 ? 4 : (set == 1 ? 3 : 2);
    for (int ji = 0; ji < njobs; ++ji) {
        CJob j;
        const int id = set * 4 + ji;
        switch (id) {
            case 0:  j = CJob{P.att_w_qkv, (bf16_t*)(P.ws + OFF_WQKV0), 18432, 2048, 18432, 0, 0}; break;
            case 1:  j = CJob{P.att_w_o, (bf16_t*)(P.ws + OFF_WO0), 2048, 2048, 2048, 0, 0}; break;
            case 2:  j = CJob{P.ffn_w_up, (bf16_t*)(P.ws + OFF_WUP0), 11264, 2048, 11264, 1, 0}; break;
            case 3:  j = CJob{P.ffn_w_down, (bf16_t*)(P.ws + OFF_WDN0), 2048, 5632, 2048, 0, 0}; break;
            case 4:  j = CJob{P.ret_w_qkvg, (bf16_t*)(P.ws + OFF_WRQKV), 12288, 2048, 8192, 0, 0}; break;
            case 5:  j = CJob{P.ret_w_qkvg, (bf16_t*)(P.ws + OFF_WRG), 12288, 2048, 4096, 0, 8192}; break;
            case 6:  j = CJob{P.ret_w_o, (bf16_t*)(P.ws + OFF_WRO), 2048, 4096, 2048, 0, 0}; break;
            case 8:  j = CJob{P.ffn_w_up + (size_t)2048 * 11264, (bf16_t*)(P.ws + OFF_WUP1), 11264, 2048, 11264, 1, 0}; break;
            default: j = CJob{P.ffn_w_down + (size_t)5632 * 2048, (bf16_t*)(P.ws + OFF_WDN1), 2048, 5632, 2048, 0, 0}; break;
        }
        convert_w(j, lw);
    }
}

DI void mod_gemv(const Params& P, LAS float* lf) {
    const int tid = tidx();
    if (bidx() >= 192) return;
    for (int i = tid; i < 8 * 2048; i += NTHREADS) lf[i] = silu_f(P.c[i]);
    __syncthreads();
    LAS float* red = lf + 16384;
    float* mod = (float*)(P.ws + OFF_MOD);
    const int cq = tid & 31, kg = tid >> 5;
    for (int item = bidx(); item < 192; item += gridDim.x) {
        const int l = item / 96, nb = item % 96;
        const float* w = P.w_mod + ((size_t)l * 2048 + kg * 128) * MODW + nb * 128 + cq * 4;
        f32x4 acc[8];
#pragma unroll
        for (int b = 0; b < 8; ++b) acc[b] = (f32x4){0.f, 0.f, 0.f, 0.f};
        const LAS float* cs = lf + kg * 128;
#pragma unroll 1
        for (int k0 = 0; k0 < 128; k0 += 8) {
            f32x4 wv[8];
#pragma unroll
            for (int kk = 0; kk < 8; ++kk) wv[kk] = *(const f32x4*)(w + (size_t)(k0 + kk) * MODW);
#pragma unroll
            for (int kk = 0; kk < 8; ++kk)
#pragma unroll
                for (int b = 0; b < 8; ++b) acc[b] += wv[kk] * cs[b * 2048 + k0 + kk];
        }
#pragma unroll
        for (int b = 0; b < 8; ++b) *(LAS f32x4*)(red + (kg * 8 + b) * 128 + cq * 4) = acc[b];
        __syncthreads();
        for (int i = tid; i < 1024; i += NTHREADS) { const int b = i >> 7, cc = i & 127;
            float sum = 0.f;
#pragma unroll
            for (int g = 0; g < 16; ++g) sum += red[(g * 8 + b) * 128 + cc];
            mod[(size_t)(l * 8 + b) * MODW + nb * 128 + cc] = sum + P.b_mod[l * MODW + nb * 128 + cc]; }
        __syncthreads();
    }
}
DI void rotary_tables(const Params& P) {
    float* cosT = (float*)(P.ws + OFF_COS); float* sinT = (float*)(P.ws + OFF_SIN);
    for (int i = bidx() * NTHREADS + tidx(); i < 4096 * 128; i += gridDim.x * NTHREADS) {
        const int s = i >> 7, jx = i & 127;
        const float inv = 1.0f / exp2f((float)jx * (13.287712379549449f / 127.0f));
        const float ang = (float)s * inv;
        const float nn = rintf(ang * 0.15915494309189535f);
        float r = fmaf(-nn, 6.2831854820251465f, ang); r = fmaf(-nn, -1.7484555e-07f, r);
        cosT[i] = __cosf(r); sinT[i] = __sinf(r);
    }
}

template <bool SRCBF> DI void norm_phase(const Params& P, int l, int which) {
    const float* src = (l == 0 && which == 0) ? P.x : P.out;
    const bf16_t* srcb = which ? (const bf16_t*)(P.ws + (l == 0 ? OFF_XB1 : OFF_XB3)) : (const bf16_t*)P.out;
    const float* gain = (which ? P.norm_ffn : P.norm_mix) + l * DM;
    const float* mod = (const float*)(P.ws + OFF_MOD) + (size_t)l * 8 * MODW;
    bf16_t* H = (bf16_t*)(P.ws + OFF_H);
    const int lane = tidx() & 63, gw = bidx() * 8 + (tidx() >> 6), nw = gridDim.x * 8;
    for (int blk = gw; blk < TTOK / 16; blk += nw) {
        const int rbase = blk * 16, b = rbase >> 12;
        const float* sh = mod + (size_t)b * MODW + (which ? 3 : 0) * DM; const float* sc = mod + (size_t)b * MODW + (which ? 4 : 1) * DM;
        f32x4 av[8], hv[8];
#pragma unroll
        for (int i = 0; i < 8; ++i) { const int cc = 4 * lane + 256 * i; const f32x4 gv = *(const f32x4*)(gain + cc), sv = *(const f32x4*)(sc + cc); hv[i] = *(const f32x4*)(sh + cc);
#pragma unroll
            for (int e = 0; e < 4; ++e) av[i][e] = gv[e] * (1.0f + sv[e]); }
#pragma unroll 1
        for (int rp = 0; rp < 8; ++rp) {
            const int row0 = rbase + 2 * rp;
            f32x4 v[2][8]; float ss0 = 0.f, ss1 = 0.f;
            if constexpr (SRCBF) { const bf16_t* xb = srcb + (size_t)row0 * DM;
#pragma unroll
                for (int i = 0; i < 8; ++i) { const u32x2 t0 = *(const u32x2*)(xb + 4 * lane + 256 * i), t1 = *(const u32x2*)(xb + DM + 4 * lane + 256 * i);
                    v[0][i] = (f32x4){bf_lo(t0.x), bf_hi(t0.x), bf_lo(t0.y), bf_hi(t0.y)}; v[1][i] = (f32x4){bf_lo(t1.x), bf_hi(t1.x), bf_lo(t1.y), bf_hi(t1.y)}; } }
            else { const float* xr = src + (size_t)row0 * DM;
#pragma unroll
                for (int i = 0; i < 8; ++i) { v[0][i] = *(const f32x4*)(xr + 4 * lane + 256 * i); v[1][i] = *(const f32x4*)(xr + DM + 4 * lane + 256 * i); } }
#pragma unroll
            for (int i = 0; i < 8; ++i) { ss0 += v[0][i][0] * v[0][i][0] + v[0][i][1] * v[0][i][1] + v[0][i][2] * v[0][i][2] + v[0][i][3] * v[0][i][3];
                ss1 += v[1][i][0] * v[1][i][0] + v[1][i][1] * v[1][i][1] + v[1][i][2] * v[1][i][2] + v[1][i][3] * v[1][i][3]; }
            ss0 += shx(ss0, 1); ss1 += shx(ss1, 1); ss0 += shx(ss0, 2); ss1 += shx(ss1, 2); ss0 += shx(ss0, 4); ss1 += shx(ss1, 4);
            ss0 += shx(ss0, 8); ss1 += shx(ss1, 8); ss0 += shx(ss0, 16); ss1 += shx(ss1, 16); ss0 += shx(ss0, 32); ss1 += shx(ss1, 32);
            const float rs0 = rsqrtf(ss0 * (1.0f / 2048.0f) + NEPS), rs1 = rsqrtf(ss1 * (1.0f / 2048.0f) + NEPS);
            bf16_t* hr = H + (size_t)row0 * DM;
#pragma unroll
            for (int i = 0; i < 8; ++i) { const int cc = 4 * lane + 256 * i;
                f32x4 o0, o1;
#pragma unroll
                for (int e = 0; e < 4; ++e) { o0[e] = v[0][i][e] * rs0 * av[i][e] + hv[i][e]; o1[e] = v[1][i][e] * rs1 * av[i][e] + hv[i][e]; }
                u32x2 w0, w1; w0.x = cvt_pk_bf16(o0[0], o0[1]); w0.y = cvt_pk_bf16(o0[2], o0[3]); w1.x = cvt_pk_bf16(o1[0], o1[1]); w1.y = cvt_pk_bf16(o1[2], o1[3]);
                *(u32x2*)(hr + cc) = w0; *(u32x2*)(hr + DM + cc) = w1; }
        }
    }
}
DI int t5_bucket(int dist) {
    if (dist < 16) return dist;
    const float v = logf((float)dist / 16.0f) / 4.852030263919617f * 16.0f;
    const int lg = 16 + (int)v;
    return lg < 31 ? lg : 31;
}
#define MFMA16(a, b, c) __builtin_amdgcn_mfma_f32_16x16x32_bf16((a), (b), (c), 0, 0, 0)
DI bf16x8 gather_col(const LAS unsigned char* p0, const LAS unsigned char* p1, int stride) {
    bf16x8 r;
    r[0] = *(const LAS short*)(p0); r[1] = *(const LAS short*)(p0 + stride); r[2] = *(const LAS short*)(p0 + 2 * stride); r[3] = *(const LAS short*)(p0 + 3 * stride);
    r[4] = *(const LAS short*)(p1); r[5] = *(const LAS short*)(p1 + stride); r[6] = *(const LAS short*)(p1 + 2 * stride); r[7] = *(const LAS short*)(p1 + 3 * stride);
    return r;
}
typedef short s16x4 __attribute__((ext_vector_type(4)));
DI bf16x8 tr_frag(const LAS unsigned char* p0, const LAS unsigned char* p1) {
    const s16x4 lo = __builtin_amdgcn_ds_read_tr16_b64_v4i16((LAS s16x4*)p0), hi = __builtin_amdgcn_ds_read_tr16_b64_v4i16((LAS s16x4*)p1);
    return __builtin_shufflevector(lo, hi, 0, 1, 2, 3, 4, 5, 6, 7);
}
DI bf16x8 pack8(const float* f) { u32x4 w; w.x = cvt_pk_bf16(f[0], f[1]); w.y = cvt_pk_bf16(f[2], f[3]); w.z = cvt_pk_bf16(f[4], f[5]); w.w = cvt_pk_bf16(f[6], f[7]); return __builtin_bit_cast(bf16x8, w); }

#define ATT_RAW_BAR() do { asm volatile("s_waitcnt lgkmcnt(0)" ::: "memory"); __builtin_amdgcn_s_barrier(); asm volatile("" ::: "memory"); } while (0)
DI void attn_phase(const Params& P, LAS unsigned char* L) {
    const bf16_t* QKV = (const bf16_t*)(P.ws + OFF_QKVC);
    bf16_t* OG = (bf16_t*)(P.ws + OFF_OG); float* LSE = (float*)(P.ws + OFF_LSE);
    const int tid = tidx(), lane = tid & 63, w = __builtin_amdgcn_readfirstlane(tid >> 6), fr = lane & 15, fq = lane >> 4;
    LAS unsigned char* Ks = L; LAS unsigned char* Vs = L + 65536; LAS float* biasL = (LAS float*)(L + 131072);
    const int ch = tid & 15, krow = tid >> 4;
    int vtr[8];
#pragma unroll
    for (int dt = 0; dt < 8; ++dt) vtr[dt] = (4 * fq + (fr >> 2)) * 256 + ((dt ^ (4 * (fq & 1) + (fr >> 2))) << 5) + (fr & 3) * 8;
    for (int sg = bidx(); sg < 768; sg += gridDim.x) {
        const int it0 = sg * 4;
        const int blk0 = it0 & 31, h = (it0 >> 5) & 15, gb = it0 >> 9, g = gb % 3, bb = gb / 3;
        const int l2d = 2 * g, dil = 1 << l2d, nbl2 = 5 - l2d, nbm = (32 >> l2d) - 1;
        const size_t rowbase = (size_t)bb * 4096;
        const int colq = g * 6144 + h * 128;
        const bf16_t* qkv_c = QKV + colq;
        const f32x4 kg0 = *(const f32x4*)(P.att_k_gain + g * 128 + ch * 8), kg1 = *(const f32x4*)(P.att_k_gain + g * 128 + ch * 8 + 4);
        u32x4 ka[4], va[4], qraw[4], qnext[4];
        auto load_block = [&](int r_, int n_) {
#pragma unroll
            for (int i = 0; i < 4; ++i) { const int idx = n_ * 128 + krow + 32 * i;
                const bf16_t* p = qkv_c + (rowbase + (size_t)idx * dil + r_) * 18432 + ch * 8; ka[i] = *(const u32x4*)(p + 2048); va[i] = *(const u32x4*)(p + 4096); } };
        auto stage_block = [&](int half) {
#pragma unroll
            for (int i = 0; i < 4; ++i) { const int row = half * 128 + krow + 32 * i; const u32x4 kv = ka[i];
                float f[8] = {bf_lo(kv.x), bf_hi(kv.x), bf_lo(kv.y), bf_hi(kv.y), bf_lo(kv.z), bf_hi(kv.z), bf_lo(kv.w), bf_hi(kv.w)};
                float ss = 0.f;
#pragma unroll
                for (int e = 0; e < 8; ++e) ss += f[e] * f[e];
                ss += shx(ss, 1); ss += shx(ss, 2); ss += shx(ss, 4); ss += shx(ss, 8);
                const float rk = rsqrtf(ss * (1.0f / 128.0f) + NEPS);
#pragma unroll
                for (int e = 0; e < 4; ++e) { f[e] *= rk * kg0[e]; f[4 + e] *= rk * kg1[e]; }
                *(LAS bf16x8*)(Ks + row * 256 + ((ch ^ (row & 15)) << 4)) = pack8(f);
                *(LAS u32x4*)(Vs + row * 256 + (((ch >> 1) ^ (row & 7)) << 5) + (ch & 1) * 16) = va[i]; } };
        auto load_q = [&](int r_, int n_, u32x4* dst) {
            const size_t qrow_ = rowbase + (size_t)(n_ * 128 + 16 * w + fr) * dil + r_;
            const bf16_t* qp = qkv_c + qrow_ * 18432 + 8 * fq;
#pragma unroll
            for (int ks = 0; ks < 4; ++ks) dst[ks] = *(const u32x4*)(qp + 32 * ks); };
        const int r0 = blk0 >> nbl2, n0 = blk0 & nbm;
        if (tid < 129) { const int bk = t5_bucket(tid * dil); biasL[tid] = P.rel_bias[bk * 48 + g * 16 + h] * LOG2E; }
        if (tid >= 256 && tid < 384) biasL[132 + tid - 256] = P.att_q_gain[g * 128 + tid - 256];
        if (n0 > 0) { load_block(r0, n0 - 1); stage_block((n0 - 1) & 1); }
        else {
#pragma unroll
            for (int i = 0; i < 4; ++i) { const int row = 128 + krow + 32 * i; *(LAS u32x4*)(Ks + row * 256 + ch * 16) = (u32x4){0u, 0u, 0u, 0u}; *(LAS u32x4*)(Vs + row * 256 + ch * 16) = (u32x4){0u, 0u, 0u, 0u}; } }
        load_block(r0, n0); stage_block(n0 & 1);
        load_q(r0, n0, qraw);
        __syncthreads();
#pragma unroll 1
        for (int i4 = 0; i4 < 4; ++i4) {
            const int blk = blk0 + i4, r = blk >> nbl2, n = blk & nbm;
            const int blkn = blk + 1, rn = blkn >> nbl2, nn = blkn & nbm;
            const size_t qrow = rowbase + (size_t)(n * 128 + 16 * w + fr) * dil + r;
            bf16x8 qf[4];
            {
                float ss = 0.f;
#pragma unroll
                for (int ks = 0; ks < 4; ++ks) {
                    const float f[8] = {bf_lo(qraw[ks].x), bf_hi(qraw[ks].x), bf_lo(qraw[ks].y), bf_hi(qraw[ks].y), bf_lo(qraw[ks].z), bf_hi(qraw[ks].z), bf_lo(qraw[ks].w), bf_hi(qraw[ks].w)};
#pragma unroll
                    for (int e = 0; e < 8; ++e) ss += f[e] * f[e]; }
                ss += shx(ss, 16); ss += shx(ss, 32);
                const float rq = rsqrtf(ss * (1.0f / 128.0f) + NEPS) * (0.08838834764831845f * LOG2E);
#pragma unroll
                for (int ks = 0; ks < 4; ++ks) { const LAS float* gp = biasL + 132 + 32 * ks + 8 * fq; const f32x4 g0 = *(const LAS f32x4*)gp, g1 = *(const LAS f32x4*)(gp + 4);
                    float f[8] = {bf_lo(qraw[ks].x), bf_hi(qraw[ks].x), bf_lo(qraw[ks].y), bf_hi(qraw[ks].y), bf_lo(qraw[ks].z), bf_hi(qraw[ks].z), bf_lo(qraw[ks].w), bf_hi(qraw[ks].w)};
#pragma unroll
                    for (int e = 0; e < 4; ++e) { f[e] *= rq * g0[e]; f[4 + e] *= rq * g1[e]; }
                    qf[ks] = pack8(f); }
            }
            if (i4 < 3) { load_block(rn, nn); load_q(rn, nn, qnext); }
            f32x4 sc[9];
            {
                bf16x8 kfa[2][4];
                auto load_kf = [&](int tt, bf16x8* dst) { const int t = w + tt; const int row = (((n + 1 + (t >> 3)) & 1) << 7) + ((t & 7) << 4) + fr;
#pragma unroll
                    for (int ks = 0; ks < 4; ++ks) dst[ks] = *(const LAS bf16x8*)(Ks + row * 256 + (((4 * ks + fq) ^ fr) << 4)); };
                load_kf(0, kfa[0]);
#pragma unroll
                for (int tt = 0; tt < 9; ++tt) {
                    if (tt + 1 < 9) load_kf(tt + 1, kfa[(tt + 1) & 1]);
                    __builtin_amdgcn_sched_barrier(0);
                    f32x4 a = (f32x4){0.f, 0.f, 0.f, 0.f};
#pragma unroll
                    for (int ks = 0; ks < 4; ++ks) a = MFMA16(kfa[tt & 1][ks], qf[ks], a);
                    sc[tt] = a;
                    __builtin_amdgcn_sched_barrier(0);
                }
            }
            float mx = -3.0e38f;
#pragma unroll
            for (int tt = 0; tt < 9; ++tt)
#pragma unroll
                for (int j = 0; j < 4; ++j) { const int delta = 128 + fr - 16 * tt - 4 * fq - j; const int ki = 16 * (w + tt) + 4 * fq + j;
                    const bool valid = (delta >= 0) && (delta <= 128) && (n > 0 || ki >= 128);
                    const int dc = delta < 0 ? 0 : (delta > 128 ? 128 : delta);
                    const float s = valid ? sc[tt][j] + biasL[dc] : -1.0e30f;
                    sc[tt][j] = s; mx = fmaxf(mx, s); }
            mx = fmaxf(mx, shx(mx, 16)); mx = fmaxf(mx, shx(mx, 32));
            float sum = 0.f;
#pragma unroll
            for (int tt = 0; tt < 9; ++tt)
#pragma unroll
                for (int j = 0; j < 4; ++j) { const float p = __builtin_amdgcn_exp2f(sc[tt][j] - mx); sc[tt][j] = p; sum += p; }
            sum += shx(sum, 16); sum += shx(sum, 32);
            f32x4 oacc[8];
#pragma unroll
            for (int dt = 0; dt < 8; ++dt) oacc[dt] = (f32x4){0.f, 0.f, 0.f, 0.f};
            bf16x8 pb[5];
#pragma unroll
            for (int s2 = 0; s2 < 5; ++s2) { float pf[8];
#pragma unroll
                for (int j = 0; j < 4; ++j) { pf[j] = sc[2 * s2][j]; pf[4 + j] = (2 * s2 + 1 <= 8) ? sc[(2 * s2 + 1 <= 8) ? 2 * s2 + 1 : 8][j] : 0.f; }
                pb[s2] = pack8(pf); }
            {
                bf16x8 vfa[2][2];
                auto load_vf = [&](int hb, bf16x8* dst) { const int s2 = hb >> 2, dh = (hb & 3) * 2;
                    const int t0 = w + 2 * s2; int t1 = w + 2 * s2 + 1; t1 = t1 > 15 ? 15 : t1;
                    const int rw0 = (((n + 1 + (t0 >> 3)) & 1) << 7) + ((t0 & 7) << 4), rw1 = (((n + 1 + (t1 >> 3)) & 1) << 7) + ((t1 & 7) << 4);
                    const LAS unsigned char* v0 = Vs + rw0 * 256; const LAS unsigned char* v1 = Vs + rw1 * 256;
#pragma unroll
                    for (int d = 0; d < 2; ++d) dst[d] = tr_frag(v0 + vtr[dh + d], v1 + vtr[dh + d]); };
                load_vf(0, vfa[0]);
#pragma unroll
                for (int hb = 0; hb < 20; ++hb) {
                    if (hb + 1 < 20) load_vf(hb + 1, vfa[(hb + 1) & 1]);
                    __builtin_amdgcn_sched_barrier(0);
#pragma unroll
                    for (int d = 0; d < 2; ++d) oacc[(hb & 3) * 2 + d] = MFMA16(vfa[hb & 1][d], pb[hb >> 2], oacc[(hb & 3) * 2 + d]);
                    __builtin_amdgcn_sched_barrier(0);
                }
            }
            const float inv = 1.0f / sum;
            bf16_t* op = OG + ((size_t)g * 8192 + qrow) * 2048 + h * 128 + 4 * fq;
#pragma unroll
            for (int dt = 0; dt < 8; ++dt) { u32x2 wv; wv.x = cvt_pk_bf16(oacc[dt][0] * inv, oacc[dt][1] * inv); wv.y = cvt_pk_bf16(oacc[dt][2] * inv, oacc[dt][3] * inv); *(u32x2*)(op + 16 * dt) = wv; }
            if (fq == 0) LSE[((size_t)g * 8192 + qrow) * 16 + h] = mx + __log2f(sum);
            ATT_RAW_BAR();
            if (i4 < 3) { stage_block(nn & 1);
#pragma unroll
                for (int ks = 0; ks < 4; ++ks) qraw[ks] = qnext[ks]; }
            ATT_RAW_BAR();
        }
    }
}
DI void merge_phase(const Params& P, int cb) {
    const bf16_t* OG = (const bf16_t*)(P.ws + OFF_OG); const float* LSE = (const float*)(P.ws + OFF_LSE);
    bf16_t* O = (bf16_t*)(P.ws + OFF_O) + (size_t)cb * 8192 * 2048;
    const int tid = tidx();
    const int c8 = (tid & 255) * 8, h = c8 >> 7;
    for (int pr0 = bidx() * 4; pr0 < 4096; pr0 += gridDim.x * 4) {
        float l[4][3]; u32x4 a[4][3];
#pragma unroll
        for (int q = 0; q < 4; ++q) { const int tok = (pr0 + q) * 2 + (tid >> 8);
#pragma unroll
            for (int g = 0; g < 3; ++g) { l[q][g] = LSE[((size_t)g * 8192 + tok) * 16 + h]; a[q][g] = *(const u32x4*)(OG + ((size_t)g * 8192 + tok) * 2048 + c8); } }
#pragma unroll
        for (int q = 0; q < 4; ++q) { const int tok = (pr0 + q) * 2 + (tid >> 8);
            const float m = fmaxf(l[q][0], fmaxf(l[q][1], l[q][2]));
            float w0 = __builtin_amdgcn_exp2f(l[q][0] - m), w1 = __builtin_amdgcn_exp2f(l[q][1] - m), w2 = __builtin_amdgcn_exp2f(l[q][2] - m);
            const float inv = 1.0f / (w0 + w1 + w2); w0 *= inv; w1 *= inv; w2 *= inv;
            const u32x4 x = a[q][0], y = a[q][1], z = a[q][2];
            u32x4 o;
            o.x = cvt_pk_bf16(w0 * bf_lo(x.x) + w1 * bf_lo(y.x) + w2 * bf_lo(z.x), w0 * bf_hi(x.x) + w1 * bf_hi(y.x) + w2 * bf_hi(z.x));
            o.y = cvt_pk_bf16(w0 * bf_lo(x.y) + w1 * bf_lo(y.y) + w2 * bf_lo(z.y), w0 * bf_hi(x.y) + w1 * bf_hi(y.y) + w2 * bf_hi(z.y));
            o.z = cvt_pk_bf16(w0 * bf_lo(x.z) + w1 * bf_lo(y.z) + w2 * bf_lo(z.z), w0 * bf_hi(x.z) + w1 * bf_hi(y.z) + w2 * bf_hi(z.z));
            o.w = cvt_pk_bf16(w0 * bf_lo(x.w) + w1 * bf_lo(y.w) + w2 * bf_lo(z.w), w0 * bf_hi(x.w) + w1 * bf_hi(y.w) + w2 * bf_hi(z.w));
            *(u32x4*)(O + (size_t)tok * 2048 + c8) = o; }
    }
}
DI int swz32(int chunk, int row) { return (((chunk & 15) ^ (row & 15)) | (chunk & 16)) << 4; }
#define RAW_BAR() do { asm volatile("s_waitcnt lgkmcnt(0)" ::: "memory"); __builtin_amdgcn_s_barrier(); asm volatile("" ::: "memory"); } while (0)
DI void scan_phase(const Params& P, LAS unsigned char* L) {
    const bf16_t* RQ = (const bf16_t*)(P.ws + OFF_RQ); const bf16_t* RK = (const bf16_t*)(P.ws + OFF_RK); const bf16_t* RV = (const bf16_t*)(P.ws + OFF_RV);
    bf16_t* RO = (bf16_t*)(P.ws + OFF_RO); float* SSQ = (float*)(P.ws + OFF_SSQ);
    const int tid = tidx(), lane = tid & 63, w = __builtin_amdgcn_readfirstlane(tid >> 6), fr = lane & 15, fq = lane >> 4;
    LAS unsigned char* S = L; LAS unsigned char* Kb = L + 65536; LAS unsigned char* Vs = L + 131072;
    int xb[4], ktr[2], wb[2], vtr[8];
    const int q4 = fr >> 2, p4 = fr & 3;
#pragma unroll
    for (int a = 0; a < 4; ++a) xb[a] = fr * 512 + (((4 * a + fq) ^ fr) << 4);
#pragma unroll
    for (int a = 0; a < 2; ++a) {
        ktr[a] = (4 * fq + q4) * 512 + ((((4 * w + 2 * a + (p4 >> 1)) & 15) ^ (4 * fq + q4)) << 4) + ((w >> 2) << 8) + (p4 & 1) * 8;
        wb[a] = fr * 512 + ((((4 * w + 2 * a + (fq >> 1)) & 15) ^ fr) << 4) + ((w >> 2) << 8) + (fq & 1) * 8; }
#pragma unroll
    for (int vt = 0; vt < 8; ++vt) vtr[vt] = (4 * fq + q4) * 256 + ((vt ^ (4 * (fq & 1) + q4)) << 5) + p4 * 8;
    const int km = lane >> 5, kcp = lane & 31;
    const int vm = lane >> 4, vcp = lane & 15;
    const unsigned kgo = (unsigned)(km * 2048 + ((kcp & 16) | ((kcp & 15) ^ ((2 * w + km) & 15))) * 8);
    const unsigned vgo = (unsigned)(vm * 4096 + ((((vcp >> 1) ^ ((4 * w + vm) & 7)) << 1) | (vcp & 1)) * 8);
    for (int it = bidx(); it < 256; it += gridDim.x) {
        const int vs = it & 3, h = (it >> 2) & 7, b = it >> 5;
        const float l2g = __log2f(1.0f - exp2f(-5.0f - (float)h));
        const float gC = exp2f(128.0f * l2g);
        f32x4 sacc[2][8];
#pragma unroll
        for (int a = 0; a < 2; ++a)
#pragma unroll
            for (int v = 0; v < 8; ++v) sacc[a][v] = (f32x4){0.f, 0.f, 0.f, 0.f};
        __syncthreads();
#pragma unroll
        for (int i = 0; i < 8; ++i) *(LAS u32x4*)(S + (tid + 512 * i) * 16) = (u32x4){0u, 0u, 0u, 0u};
        auto stage_kv = [&](size_t t0) {
#pragma unroll
            for (int i = 0; i < 8; ++i) { const bf16_t* kp = RK + (t0 + 16 * i + 2 * w) * 2048 + h * 256;
                __builtin_amdgcn_global_load_lds((const unsigned*)(kp + kgo), (LAS unsigned*)(Kb + (i * 8 + w) * 1024), 16, 0, 0); }
#pragma unroll
            for (int i = 0; i < 4; ++i) { const bf16_t* vp = RV + (t0 + 32 * i + 4 * w) * 4096 + h * 512 + vs * 128;
                __builtin_amdgcn_global_load_lds((const unsigned*)(vp + vgo), (LAS unsigned*)(Vs + (i * 8 + w) * 1024), 16, 0, 0); } };
        bf16x8 qf[8];
        auto load_q = [&](size_t t0) { const bf16_t* qp = RQ + (t0 + 16 * w) * 2048 + h * 256; const unsigned qo = (unsigned)(fr * 2048 + 8 * fq);
#pragma unroll
            for (int ks = 0; ks < 8; ++ks) qf[ks] = *(const bf16x8*)(qp + (qo + 32 * ks)); };
        load_q((size_t)b * 4096); stage_kv((size_t)b * 4096);
        __syncthreads();
        for (int c = 0; c < 32; ++c) {
            const size_t t0 = (size_t)b * 4096 + c * 128;
            f32x4 oacc[8];
#pragma unroll
            for (int vt = 0; vt < 8; ++vt) { f32x4 a = (f32x4){0.f, 0.f, 0.f, 0.f}; bf16x8 sfa[8];
#pragma unroll
                for (int ks = 0; ks < 8; ++ks) sfa[ks] = *(const LAS bf16x8*)(S + vt * 8192 + xb[ks & 3] + (ks >> 2) * 256);
                __builtin_amdgcn_sched_barrier(0);
#pragma unroll
                for (int ks = 0; ks < 8; ++ks) a = MFMA16(sfa[ks], qf[ks], a);
                oacc[vt] = a; }
            asm volatile("s_waitcnt vmcnt(0)" ::: "memory");
            RAW_BAR();
            unsigned pk[8][2];
#pragma unroll
            for (int mt = 0; mt < 8; ++mt) {
                f32x4 a = (f32x4){0.f, 0.f, 0.f, 0.f};
                if (mt <= w) {
                    bf16x8 kfa[8];
#pragma unroll
                    for (int ks = 0; ks < 8; ++ks) kfa[ks] = *(const LAS bf16x8*)(Kb + mt * 8192 + xb[ks & 3] + (ks >> 2) * 256);
                    __builtin_amdgcn_sched_barrier(0);
#pragma unroll
                    for (int ks = 0; ks < 8; ++ks) a = MFMA16(kfa[ks], qf[ks], a);
#pragma unroll
                    for (int j = 0; j < 4; ++j) a[j] = (mt < w || 4 * fq + j <= fr) ? a[j] : 0.f; }
                pk[mt][0] = cvt_pk_bf16(a[0], a[1]); pk[mt][1] = cvt_pk_bf16(a[2], a[3]); }
            const size_t tn = t0 + (c + 1 < 32 ? 128 : 0);
            load_q(tn);
#pragma unroll
            for (int ms = 0; ms < 4; ++ms) {
                u32x4 pw; pw.x = pk[2 * ms][0]; pw.y = pk[2 * ms][1]; pw.z = pk[2 * ms + 1][0]; pw.w = pk[2 * ms + 1][1];
                const bf16x8 pb = __builtin_bit_cast(bf16x8, pw);
                const LAS unsigned char* k0 = Kb + (32 * ms) * 512; const LAS unsigned char* v0 = Vs + (32 * ms) * 256;
                const bf16x8 kf0 = tr_frag(k0 + ktr[0], k0 + 16 * 512 + ktr[0]), kf1 = tr_frag(k0 + ktr[1], k0 + 16 * 512 + ktr[1]);
#pragma unroll
                for (int vt = 0; vt < 8; ++vt) { const bf16x8 vf = tr_frag(v0 + vtr[vt], v0 + 16 * 256 + vtr[vt]);
                    if (2 * ms <= w) oacc[vt] = MFMA16(vf, pb, oacc[vt]);
                    sacc[0][vt] = MFMA16(kf0, vf, sacc[0][vt]); sacc[1][vt] = MFMA16(kf1, vf, sacc[1][vt]); }
            }
            {
                const float dn = exp2f((float)(16 * w + fr + 1) * l2g);
                bf16_t* op = RO + (t0 + 16 * w) * 4096 + h * 512 + vs * 128 + (unsigned)(fr * 4096 + 4 * fq);
                float ss = 0.f;
#pragma unroll
                for (int vt = 0; vt < 8; ++vt) { const f32x4 o = oacc[vt] * dn; ss += o[0] * o[0] + o[1] * o[1] + o[2] * o[2] + o[3] * o[3];
                    u32x2 wv; wv.x = cvt_pk_bf16(o[0], o[1]); wv.y = cvt_pk_bf16(o[2], o[3]); *(u32x2*)(op + 16 * vt) = wv; }
                ss += shx(ss, 16); ss += shx(ss, 32);
                if (fq == 0) (SSQ + (t0 + 16 * w) * 32 + h * 4 + vs)[(unsigned)(fr * 32)] = ss;
            }
#pragma unroll
            for (int a = 0; a < 2; ++a)
#pragma unroll
                for (int v = 0; v < 8; ++v) sacc[a][v] *= gC;
            RAW_BAR();
#pragma unroll
            for (int ks = 0; ks < 8; ++ks) asm volatile("" :: "v"(qf[ks]));
            stage_kv(tn);
#pragma unroll
            for (int a = 0; a < 2; ++a)
#pragma unroll
                for (int vt = 0; vt < 8; ++vt) {
                    u32x2 wv; wv.x = cvt_pk_bf16(sacc[a][vt][0], sacc[a][vt][1]); wv.y = cvt_pk_bf16(sacc[a][vt][2], sacc[a][vt][3]);
                    *(LAS u32x2*)(S + vt * 8192 + wb[a]) = wv; }
            RAW_BAR();
        }
    }
}

constexpr int NPH = 23;
constexpr int MAXPH = NPH;
DI void decode_phase(int ph, int& type, int& a0, int& a1, int& a2) {
    a0 = 0; a1 = 0; a2 = -1;
    if (ph == 0) type = 0;
    else if (ph == 1) { type = 1; }
    else if (ph < 10) { const int q = (ph - 2) >> 1; a0 = q; if ((ph - 2) & 1) type = 3; else { type = 2; a1 = q > 0 ? 1 : 0; } }
    else if (ph == 10) { type = 4; a0 = 3; }
    else if (ph == 11) { type = 5; a0 = 0; }
    else if (ph == 12) { type = 1; a0 = 0; a1 = 1; }
    else if (ph == 13) { type = 6; a0 = 0; }
    else if (ph == 14) { type = 5; a0 = 1; }
    else if (ph == 15) { type = 1; a0 = 1; a1 = 0; a2 = 1; }
    else if (ph == 16) type = 7;
    else if (ph == 17) type = 8;
    else if (ph == 18) type = 9;
    else if (ph == 19) { type = 5; a0 = 2; }
    else if (ph == 20) { type = 1; a0 = 1; a1 = 1; a2 = 2; }
    else if (ph == 21) { type = 6; a0 = 1; }
    else { type = 5; a0 = 3; }
}
template <int TYPE> DI void run_phase(const Params& P, int a0, int a1, int a2, LAS unsigned char* L) {
    unsigned char* ws = P.ws; const float* mod = (const float*)(ws + OFF_MOD);
    pg8::StaticOrder S;
    if constexpr (TYPE == 0) { mod_gemv(P, (LAS float*)L); rotary_tables(P); __syncthreads(); convert_set(P, 0, (LAS unsigned*)L); }
    else if constexpr (TYPE == 1) { if (a2 >= 0) convert_set(P, a2, (LAS unsigned*)L); if (a0 == 0 && a1 == 0) norm_phase<false>(P, a0, a1); else norm_phase<true>(P, a0, a1); }
    else if constexpr (TYPE == 2) { if (a1) merge_phase(P, a0 - 1);
        pg8::Gemm g{(const bf16_t*)(ws + OFF_H) + (size_t)a0 * 8192 * 2048, (const bf16_t*)(ws + OFF_WQKV0), 8192, 18432, 2048};
        S.init(g.M, g.N, gridDim.x, bidx(), 4); EpiPlainBf16 E{(bf16_t*)(ws + OFF_QKVC), 18432};
        pg8::gemm_phase<EpiPlainBf16, pg8::StaticOrder>(L, g, S, E); }
    else if constexpr (TYPE == 3) attn_phase(P, L);
    else if constexpr (TYPE == 4) merge_phase(P, a0);
    else if constexpr (TYPE == 5) {
        const size_t offA = a0 == 0 ? OFF_O : (a0 == 1 ? OFF_HID0 : (a0 == 2 ? OFF_RO : OFF_HID1));
        const size_t offB = a0 == 0 ? OFF_WO0 : (a0 == 1 ? OFF_WDN0 : (a0 == 2 ? OFF_WRO : OFF_WDN1));
        const int kk = a0 == 0 ? 2048 : (a0 == 2 ? 4096 : DFF);
        const int goff = ((a0 >= 2) ? 8 * MODW : 0) + ((a0 & 1) ? 5 * DM : 2 * DM);
        pg8::Gemm g{(const bf16_t*)(ws + offA), (const bf16_t*)(ws + offB), TTOK, DM, kk};
        S.init(g.M, g.N, gridDim.x, bidx(), 4);
        if (a0 == 0) { EpiResidF2B E{P.x, (bf16_t*)(ws + OFF_XB1), mod + goff}; pg8::gemm_phase<EpiResidF2B, pg8::StaticOrder>(L, g, S, E); }
        else if (a0 == 3) { EpiResidB2F E{(const bf16_t*)(ws + OFF_XB3), P.out, mod + goff}; pg8::gemm_phase<EpiResidB2F, pg8::StaticOrder>(L, g, S, E); }
        else { EpiResidB2B E{a0 == 1 ? (const bf16_t*)(ws + OFF_XB1) : (const bf16_t*)P.out, a0 == 1 ? (bf16_t*)P.out : (bf16_t*)(ws + OFF_XB3), mod + goff};
               pg8::gemm_phase<EpiResidB2B, pg8::StaticOrder>(L, g, S, E); } }
    else if constexpr (TYPE == 6) { pg8::Gemm g{(const bf16_t*)(ws + OFF_H), (const bf16_t*)(ws + (a0 ? OFF_WUP1 : OFF_WUP0)), TTOK, 2 * DFF, 2048};
        S.init(g.M, g.N, gridDim.x, bidx()); EpiSwiGLU E{(bf16_t*)(ws + (a0 ? OFF_HID1 : OFF_HID0))};
        pg8::gemm_phase<EpiSwiGLU, pg8::StaticOrder>(L, g, S, E); }
    else if constexpr (TYPE == 7) { pg8::Gemm g{(const bf16_t*)(ws + OFF_H), (const bf16_t*)(ws + OFF_WRQKV), TTOK, 8192, 2048};
        S.init(g.M, g.N, gridDim.x, bidx());
        EpiRetQKV E{(bf16_t*)(ws + OFF_RQ), (bf16_t*)(ws + OFF_RK), (bf16_t*)(ws + OFF_RV), (const float*)(ws + OFF_COS), (const float*)(ws + OFF_SIN)};
        pg8::gemm_phase<EpiRetQKV, pg8::StaticOrder>(L, g, S, E); }
    else if constexpr (TYPE == 8) scan_phase(P, L);
    else { pg8::Gemm g{(const bf16_t*)(ws + OFF_H), (const bf16_t*)(ws + OFF_WRG), TTOK, 4096, 2048};
        S.init(g.M, g.N, gridDim.x, bidx()); EpiRetGate E{(bf16_t*)(ws + OFF_RO), (const float*)(ws + OFF_SSQ)};
        pg8::gemm_phase<EpiRetGate, pg8::StaticOrder>(L, g, S, E); }
}
#ifndef ONE_LAUNCH
#define ONE_LAUNCH 1
#endif
#if ONE_LAUNCH
DI void grid_barrier(unsigned* ctr, unsigned target) {
    asm volatile("s_waitcnt vmcnt(0)" ::: "memory");
    __syncthreads();
    if (threadIdx.x == 0) {
        __builtin_amdgcn_fence(__ATOMIC_RELEASE, "agent");
        asm volatile("s_waitcnt vmcnt(0)" ::: "memory");
        __hip_atomic_fetch_add(ctr, 1u, __ATOMIC_RELAXED, __HIP_MEMORY_SCOPE_AGENT);
        while (__hip_atomic_load(ctr, __ATOMIC_RELAXED, __HIP_MEMORY_SCOPE_AGENT) < target) __builtin_amdgcn_s_sleep(1);
        __builtin_amdgcn_fence(__ATOMIC_ACQUIRE, "agent");
        asm volatile("s_waitcnt vmcnt(0)" ::: "memory");
    }
    __syncthreads();
}
__global__ void __launch_bounds__(NTHREADS, 2) mega_fwd(Params Pin, int ph_lo, int ph_hi) {
    extern __shared__ __attribute__((aligned(16))) unsigned char shm[];
    LAS unsigned char* L = (LAS unsigned char*)shm;
    cg::grid_group grid = cg::this_grid();
    unsigned nbar = 0;
    for (int ph = ph_lo; ph < ph_hi; ++ph) {
        typedef const Params __attribute__((address_space(4))) * KP;
        KP pk = (KP)__builtin_amdgcn_kernarg_segment_ptr();
        asm volatile("" : "+s"(pk));
        Params P;
        P.x = pk->x; P.c = pk->c; P.w_mod = pk->w_mod; P.b_mod = pk->b_mod; P.norm_mix = pk->norm_mix; P.norm_ffn = pk->norm_ffn; P.rel_bias = pk->rel_bias;
        P.att_w_qkv = pk->att_w_qkv; P.att_q_gain = pk->att_q_gain; P.att_k_gain = pk->att_k_gain; P.att_w_o = pk->att_w_o; P.ret_w_qkvg = pk->ret_w_qkvg; P.ret_w_o = pk->ret_w_o;
        P.ffn_w_up = pk->ffn_w_up; P.ffn_w_down = pk->ffn_w_down; P.out = pk->out; P.ws = pk->ws;
        int type, a0, a1, a2; decode_phase(ph, type, a0, a1, a2);
        switch (type) {
            case 0: run_phase<0>(P, a0, a1, a2, L); break; case 1: run_phase<1>(P, a0, a1, a2, L); break;
            case 2: run_phase<2>(P, a0, a1, a2, L); break; case 3: run_phase<3>(P, a0, a1, a2, L); break;
            case 4: run_phase<4>(P, a0, a1, a2, L); break; case 5: run_phase<5>(P, a0, a1, a2, L); break;
            case 6: run_phase<6>(P, a0, a1, a2, L); break; case 7: run_phase<7>(P, a0, a1, a2, L); break;
            case 8: run_phase<8>(P, a0, a1, a2, L); break; default: run_phase<9>(P, a0, a1, a2, L); break;
        }
        if (ph + 1 < ph_hi) {
            unsigned* ctr = (unsigned*)(P.ws + OFF_BAR);
            if (ph == ph_lo) { if (blockIdx.x == 0 && threadIdx.x == 0) __hip_atomic_store(ctr, 0u, __ATOMIC_RELAXED, __HIP_MEMORY_SCOPE_AGENT); grid.sync(); }
            else { ++nbar; grid_barrier(ctr, nbar * gridDim.x); }
        }
    }
}
#endif
extern "C" void kernel_launch(void* const* d_in, const int* in_sizes, int n_in, void* d_out, int out_size, void* d_ws, size_t ws_size, hipStream_t stream) {
    static int grid = 0;
    if (grid == 0) {
        int dev = 0, cus = 0;
        (void)hipGetDevice(&dev);
        (void)hipDeviceGetAttribute(&cus, hipDeviceAttributeMultiprocessorCount, dev);
        grid = cus > 0 ? cus : 256;
        if (ws_size < WS_NEED) fprintf(stderr, "kernel_launch: workspace too small: %zu < %zu\n", ws_size, (size_t)WS_NEED);
    }
    Params p{};
    p.x = (const float*)d_in[0]; p.c = (const float*)d_in[1]; p.w_mod = (const float*)d_in[2]; p.b_mod = (const float*)d_in[3]; p.norm_mix = (const float*)d_in[4]; p.norm_ffn = (const float*)d_in[5];
    p.rel_bias = (const float*)d_in[6]; p.att_w_qkv = (const float*)d_in[7]; p.att_q_gain = (const float*)d_in[8]; p.att_k_gain = (const float*)d_in[9]; p.att_w_o = (const float*)d_in[10];
    p.ret_w_qkvg = (const float*)d_in[11]; p.ret_w_o = (const float*)d_in[12]; p.ffn_w_up = (const float*)d_in[13]; p.ffn_w_down = (const float*)d_in[14];
    p.out = (float*)d_out; p.ws = (unsigned char*)d_ws;
#if ONE_LAUNCH
    static bool attr = false;
    if (!attr) { (void)hipFuncSetAttribute((const void*)mega_fwd, hipFuncAttributeMaxDynamicSharedMemorySize, LDS_BYTES); attr = true; }
    int lo = 0, hi = NPH;
    void* args[] = {&p, &lo, &hi};
    hipError_t e = hipLaunchCooperativeKernel((const void*)mega_fwd, dim3(grid), dim3(NTHREADS), args, LDS_BYTES, stream);
    if (e != hipSuccess) fprintf(stderr, "kernel_launch: cooperative launch failed: %s (grid %d)\n", hipGetErrorString(e), grid);
#endif
}
```

```cpp
#include <hip/hip_runtime.h>
#include <hip/hip_cooperative_groups.h>
#include <cstdio>
namespace cg = cooperative_groups;

#define LAS __attribute__((address_space(3)))
#define PG8_LAS LAS
typedef unsigned short bf16_t;
typedef short bf16x8 __attribute__((ext_vector_type(8)));
typedef float f32x4 __attribute__((ext_vector_type(4)));
typedef unsigned u32x4 __attribute__((ext_vector_type(4)));
typedef unsigned u32x2 __attribute__((ext_vector_type(2)));
#define DI __device__ __forceinline__

constexpr int TTOK = 32768, DM = 2048, SEQL = 4096, DFF = 5632, MODW = 12288;
constexpr float LOG2E = 1.4426950408889634f;
constexpr float NEPS = 1e-6f;
constexpr int LDS_BYTES = 163840;
constexpr int NTHREADS = 512;

constexpr size_t MB = 1048576;
constexpr size_t OFF_MOD = 0;
constexpr size_t OFF_COS = 1 * MB;
constexpr size_t OFF_SIN = 3 * MB;
constexpr size_t OFF_LSE = 5 * MB;
constexpr size_t OFF_SSQ = 8 * MB;
constexpr size_t OFF_BAR = 12 * MB;
constexpr size_t OFF_H   = 16 * MB;
constexpr size_t OFF_W   = 144 * MB;
constexpr size_t OFF_WQKV0 = OFF_W;
constexpr size_t OFF_WO0   = OFF_WQKV0 + 72 * MB;
constexpr size_t OFF_WUP0  = OFF_WO0 + 8 * MB;
constexpr size_t OFF_WDN0  = OFF_WUP0 + 44 * MB;
constexpr size_t OFF_BIG0  = OFF_WDN0 + 22 * MB;
constexpr size_t OFF_QKVC  = OFF_BIG0;
constexpr size_t OFF_OG    = OFF_QKVC + 288 * MB;
constexpr size_t OFF_O     = OFF_OG + 96 * MB;
constexpr size_t OFF_HID0  = OFF_BIG0;
constexpr size_t OFF_XB1   = 802 * MB;
constexpr size_t OFF_WRQKV = OFF_W;
constexpr size_t OFF_WRG   = OFF_WRQKV + 32 * MB;
constexpr size_t OFF_WRO   = OFF_WRG + 16 * MB;
constexpr size_t OFF_BIG1  = OFF_WRO + 16 * MB;
constexpr size_t OFF_RQ    = OFF_BIG1;
constexpr size_t OFF_RK    = OFF_RQ + 128 * MB;
constexpr size_t OFF_RV    = OFF_RK + 128 * MB;
constexpr size_t OFF_RO    = OFF_RV + 256 * MB;
constexpr size_t OFF_WUP1  = OFF_BIG1;
constexpr size_t OFF_WDN1  = OFF_WUP1 + 44 * MB;
constexpr size_t OFF_XB3   = 464 * MB;
constexpr size_t OFF_HID1  = 592 * MB;
constexpr size_t WS_NEED   = OFF_RO + 256 * MB;

struct Params {
    const float *x, *c, *w_mod, *b_mod, *norm_mix, *norm_ffn, *rel_bias, *att_w_qkv, *att_q_gain, *att_k_gain, *att_w_o, *ret_w_qkvg, *ret_w_o, *ffn_w_up, *ffn_w_down;
    float* out; unsigned char* ws;
};

DI unsigned cvt_pk_bf16(float lo, float hi) { unsigned r; asm volatile("v_cvt_pk_bf16_f32 %0, %1, %2" : "=v"(r) : "v"(lo), "v"(hi)); return r; }
DI float bf_lo(unsigned u) { return __uint_as_float(u << 16); }
DI float bf_hi(unsigned u) { return __uint_as_float(u & 0xffff0000u); }
DI float silu_f(float v) { return v * __builtin_amdgcn_rcpf(1.0f + __expf(-v)); }
DI float shx(float v, int m) { return __shfl_xor(v, m); }
DI int tidx() { int t = threadIdx.x; asm volatile("" : "+v"(t)); return t; }
DI int bidx() { int b = blockIdx.x; asm volatile("" : "+s"(b)); return b; }

namespace pg8 {
constexpr int BM = 256, BK = 64, HALF = 128, HTB = HALF * BK * 2, STAGE_BYTES = 8 * HTB, NXCD = 8, WGM = 8;
__host__ __device__ __forceinline__ int lds_byte(int r, int c) { const int st = (r >> 4) * 2 + (c >> 5), rr = r & 15, cc = c & 31, ob = rr * 64 + cc * 2; return st * 1024 + (ob ^ (((ob >> 9) & 1) << 5)); }
__host__ __device__ __forceinline__ void stage_rc(int b, int& R, int& C) { const int st = b / 1024, sb = b % 1024, swz = sb ^ (((sb >> 9) & 1) << 5); R = (st >> 1) * 16 + swz / 64; C = (st & 1) * 32 + (swz % 64) / 2; }
__host__ __device__ __forceinline__ int perm32(int rho) { const int n = rho >> 4, i = rho & 15; return 8 * (i >> 2) + 4 * n + (i & 3); }
struct Unit { int pm, pn; };
struct Gemm { const bf16_t* A; const bf16_t* Bt; int M, N, K; };
struct StaticOrder {
    int nM, nN, nwg, G, c, wgm;
    __device__ void init(int M, int N, int G_, int c_, int wgm_ = WGM) { nM = M / BM; nN = N / BM; nwg = nM * nN; G = G_; c = c_; wgm = wgm_; }
    __device__ bool next(int i, Unit& u) const {
        const long L = (long)i * G + c; if (L >= nwg) return false;
        int wgid = (int)L; { const int q = nwg / NXCD, r = nwg % NXCD, xcd = wgid % NXCD, off = wgid / NXCD; wgid = (xcd < r ? xcd * (q + 1) : r * (q + 1) + (xcd - r) * q) + off; }
        const int nig = wgm * nN, gid = wgid / nig, fm = gid * wgm, gsz = (nM - fm) < wgm ? (nM - fm) : wgm;
        u.pm = fm + ((wgid % nig) % gsz); u.pn = (wgid % nig) / gsz; return true;
    }
    __device__ __forceinline__ void a_ready(const Unit&) const {}
    __device__ __forceinline__ void done(const Unit&) const {}
};
template <class Epi, class Sched>
__device__ __forceinline__ void gemm_phase(PG8_LAS unsigned char* lds, const Gemm g, const Sched& S, const Epi& E) {
    const int tid = tidx(), wid = __builtin_amdgcn_readfirstlane(tid >> 6), lane = tid & 63, wr = wid >> 2, wc = wid & 3, fr = lane & 15, fq = lane >> 4;
    const int K = g.K, nt = K / BK;
    unsigned voffA[2], voffB[2];
#pragma unroll
    for (int i = 0; i < 2; ++i) { int R, C; stage_rc(tid * 16 + i * 8192, R, C); const int Rb = Epi::PERM ? ((R & ~31) + perm32(R & 31)) : R;
        voffA[i] = (unsigned)(R * K + C) * 2u; voffB[i] = (unsigned)(Rb * K + C) * 2u; }
    const size_t kstep = (size_t)(BK * 2);
    const size_t hstep = (size_t)HALF * K * 2;
    const size_t tstep = 2 * hstep;
    const unsigned ldsw = (unsigned)wid * 1024u;
    const int aoff = lds_byte(wr * 64 + fr, fq * 8), boff = lds_byte(wc * 32 + fr, fq * 8);
#define PG8_SA(b, h) (((b) * 2 + (h)) * HTB)
#define PG8_SB(b, h) ((4 + (b) * 2 + (h)) * HTB)
#define PG8_STAGE(bufoff, gbase, voff) do { _Pragma("unroll") for (int _i = 0; _i < 2; ++_i) \
        __builtin_amdgcn_global_load_lds((const unsigned*)((const char*)(gbase) + (voff)[_i]), (PG8_LAS unsigned*)(lds + (bufoff) + ldsw + _i * 8192), 16, 0, 0); } while (0)
#define PG8_LDA(dst, b, h) do { _Pragma("unroll") for (int m = 0; m < 4; ++m) _Pragma("unroll") for (int k = 0; k < 2; ++k) dst[m][k] = *(const PG8_LAS bf16x8*)(lds + PG8_SA(b, h) + aoff + m * 2048 + k * 1024); } while (0)
#define PG8_LDB(dst, b, h) do { _Pragma("unroll") for (int n = 0; n < 2; ++n) _Pragma("unroll") for (int k = 0; k < 2; ++k) dst[n][k] = *(const PG8_LAS bf16x8*)(lds + PG8_SB(b, h) + boff + n * 2048 + k * 1024); } while (0)
#define PG8_MMA(ai, bj, At, Bt) do { __builtin_amdgcn_s_setprio(1); _Pragma("unroll") for (int m = 0; m < 4; ++m) _Pragma("unroll") for (int n = 0; n < 2; ++n) _Pragma("unroll") for (int k = 0; k < 2; ++k) \
        acc[ai][bj][m][n] = __builtin_amdgcn_mfma_f32_16x16x32_bf16(Bt[n][k], At[m][k], acc[ai][bj][m][n], 0, 0, 0); __builtin_amdgcn_s_setprio(0); } while (0)
#define PG8_WAIT_V(n) asm volatile("s_waitcnt vmcnt(" #n ")" ::: "memory")
#define PG8_WAIT_L(n) asm volatile("s_waitcnt lgkmcnt(" #n ")" ::: "memory")
#define PG8_BAR __builtin_amdgcn_s_barrier()
#define PG8_SCHED __builtin_amdgcn_sched_barrier(0)
    Unit cur, nxt; int ui = 0;
    if (!S.next(0, cur)) return;
    f32x4 acc[2][2][4][2];
#pragma unroll
    for (int a = 0; a < 2; ++a)
#pragma unroll
        for (int b = 0; b < 2; ++b)
#pragma unroll
            for (int m = 0; m < 4; ++m)
#pragma unroll
                for (int n = 0; n < 2; ++n) acc[a][b][m][n] = (f32x4){0.f, 0.f, 0.f, 0.f};
    bf16x8 At[4][2], B0[2][2], B1[2][2];
    const char* cA = (const char*)g.A + (size_t)cur.pm * tstep; const char* cB = (const char*)g.Bt + (size_t)cur.pn * tstep;
    S.a_ready(cur);
    PG8_STAGE(PG8_SB(0, 0), cB, voffB); PG8_STAGE(PG8_SA(0, 0), cA, voffA); PG8_STAGE(PG8_SB(0, 1), cB + hstep, voffB); PG8_STAGE(PG8_SA(0, 1), cA + hstep, voffA);
    if (wr == 1) PG8_BAR;
    PG8_WAIT_V(4); PG8_BAR;
    PG8_STAGE(PG8_SB(1, 0), cB + kstep, voffB); PG8_STAGE(PG8_SA(1, 0), cA + kstep, voffA); PG8_STAGE(PG8_SB(1, 1), cB + hstep + kstep, voffB);
    PG8_WAIT_V(6); PG8_BAR;
    for (;;) {
        const bool has_next = S.next(ui + 1, nxt);
        const char* nA = has_next ? (const char*)g.A + (size_t)nxt.pm * tstep : cA; const char* nB = has_next ? (const char*)g.Bt + (size_t)nxt.pn * tstep : cB;
        for (int t = 0; t < nt; t += 2) {
            const bool last = (t == nt - 2);
            const char* a1 = cA + (size_t)(t + 1) * kstep;
            const char* a2 = last ? nA : cA + (size_t)(t + 2) * kstep; const char* b2 = last ? nB : cB + (size_t)(t + 2) * kstep;
            const char* a3 = a2 + kstep; const char* b3 = b2 + kstep;
            if (last && has_next) S.a_ready(nxt);
            PG8_LDB(B0, 0, 0); PG8_SCHED; PG8_LDA(At, 0, 0); PG8_STAGE(PG8_SA(1, 1), a1 + hstep, voffA);
            PG8_WAIT_L(8); PG8_BAR; PG8_WAIT_L(0); PG8_MMA(0, 0, At, B0); PG8_BAR; PG8_SCHED;
            PG8_LDB(B1, 0, 1); PG8_STAGE(PG8_SB(0, 0), b2, voffB);
            PG8_BAR; PG8_WAIT_L(0); PG8_MMA(0, 1, At, B1); PG8_BAR;
            PG8_LDA(At, 0, 1); PG8_STAGE(PG8_SA(0, 0), a2, voffA);
            PG8_BAR; PG8_WAIT_L(0); PG8_MMA(1, 0, At, B0); PG8_BAR; PG8_SCHED;
            PG8_STAGE(PG8_SB(0, 1), b2 + hstep, voffB);
            PG8_WAIT_V(6); PG8_BAR; PG8_MMA(1, 1, At, B1); PG8_BAR;
            PG8_LDB(B0, 1, 0); PG8_SCHED; PG8_LDA(At, 1, 0); PG8_STAGE(PG8_SA(0, 1), a2 + hstep, voffA);
            PG8_WAIT_L(8); PG8_BAR; PG8_WAIT_L(0); PG8_MMA(0, 0, At, B0); PG8_BAR; PG8_SCHED;
            PG8_LDB(B1, 1, 1); PG8_STAGE(PG8_SB(1, 0), b3, voffB);
            PG8_BAR; PG8_WAIT_L(0); PG8_MMA(0, 1, At, B1); PG8_BAR;
            PG8_LDA(At, 1, 1); PG8_STAGE(PG8_SA(1, 0), a3, voffA);
            PG8_BAR; PG8_WAIT_L(0); PG8_MMA(1, 0, At, B0); PG8_BAR; PG8_SCHED;
            PG8_STAGE(PG8_SB(1, 1), b3 + hstep, voffB);
            PG8_WAIT_V(6); PG8_BAR; PG8_MMA(1, 1, At, B1); PG8_BAR;
        }
        E(acc, cur, wr, wc, fr, fq); S.done(cur);
        if (!has_next) break;
#pragma unroll
        for (int a = 0; a < 2; ++a)
#pragma unroll
            for (int b = 0; b < 2; ++b)
#pragma unroll
                for (int m = 0; m < 4; ++m)
#pragma unroll
                    for (int n = 0; n < 2; ++n) acc[a][b][m][n] = (f32x4){0.f, 0.f, 0.f, 0.f};
        cur = nxt; cA = nA; cB = nB; ++ui;
    }
    PG8_WAIT_V(0);
    if (wr == 0) PG8_BAR;
    PG8_BAR;
#undef PG8_SA
#undef PG8_SB
#undef PG8_STAGE
#undef PG8_LDA
#undef PG8_LDB
#undef PG8_MMA
#undef PG8_WAIT_V
#undef PG8_WAIT_L
#undef PG8_BAR
#undef PG8_SCHED
}
}
using pg8::Unit;
typedef f32x4 AccT[2][2][4][2];

struct EpiPlainBf16 {
    static constexpr bool PERM = true;
    bf16_t* O; int ldc;
    DI void operator()(const AccT& acc, const Unit& u, int wr, int wc, int fr, int fq) const {
        const int row0 = u.pm * 256 + wr * 64 + fr, col0 = wc * 32 + 8 * fq;
#pragma unroll
        for (int ai = 0; ai < 2; ++ai)
#pragma unroll
            for (int m = 0; m < 4; ++m) { bf16_t* rowp = O + ((size_t)u.pn * ldc + (row0 + ai * 128 + m * 16)) * 256 + col0;
#pragma unroll
                for (int bj = 0; bj < 2; ++bj) { const f32x4 v0 = acc[ai][bj][m][0], v1 = acc[ai][bj][m][1];
                    u32x4 w; w.x = cvt_pk_bf16(v0[0], v0[1]); w.y = cvt_pk_bf16(v0[2], v0[3]); w.z = cvt_pk_bf16(v1[0], v1[1]); w.w = cvt_pk_bf16(v1[2], v1[3]);
                    *(u32x4*)(rowp + bj * 128) = w; } }
    }
};
struct EpiResid {
    static constexpr bool PERM = false;
    const float* R; float* O; const float* gate;
    DI void operator()(const AccT& acc, const Unit& u, int wr, int wc, int fr, int fq) const {
        const int row0 = u.pm * 256 + wr * 64 + fr, col0 = u.pn * 256 + wc * 32 + 4 * fq;
        const int b = (u.pm * 256) >> 12;
        f32x4 gv[2][2];
#pragma unroll
        for (int bj = 0; bj < 2; ++bj)
#pragma unroll
            for (int n = 0; n < 2; ++n) gv[bj][n] = *(const f32x4*)(gate + (size_t)b * MODW + col0 + bj * 128 + n * 16);
#pragma unroll
        for (int ai = 0; ai < 2; ++ai)
#pragma unroll
            for (int mp = 0; mp < 2; ++mp) {
                f32x4 rv[2][2][2];
#pragma unroll
                for (int mm = 0; mm < 2; ++mm) { const size_t ro = (size_t)(row0 + ai * 128 + (2 * mp + mm) * 16) * DM + col0;
#pragma unroll
                    for (int bj = 0; bj < 2; ++bj)
#pragma unroll
                        for (int n = 0; n < 2; ++n) rv[mm][bj][n] = *(const f32x4*)(R + ro + bj * 128 + n * 16); }
#pragma unroll
                for (int mm = 0; mm < 2; ++mm) { const size_t ro = (size_t)(row0 + ai * 128 + (2 * mp + mm) * 16) * DM + col0;
#pragma unroll
                    for (int bj = 0; bj < 2; ++bj)
#pragma unroll
                        for (int n = 0; n < 2; ++n) *(f32x4*)(O + ro + bj * 128 + n * 16) = rv[mm][bj][n] + gv[bj][n] * acc[ai][bj][2 * mp + mm][n]; }
            }
    }
};
struct EpiResidF2B {
    static constexpr bool PERM = true;
    const float* R; bf16_t* O; const float* gate;
    DI void operator()(const AccT& acc, const Unit& u, int wr, int wc, int fr, int fq) const {
        const int row0 = u.pm * 256 + wr * 64 + fr, col0 = u.pn * 256 + wc * 32 + 8 * fq;
        const int b = (u.pm * 256) >> 12;
        f32x4 gv[2][2];
#pragma unroll
        for (int bj = 0; bj < 2; ++bj)
#pragma unroll
            for (int n = 0; n < 2; ++n) gv[bj][n] = *(const f32x4*)(gate + (size_t)b * MODW + col0 + bj * 128 + n * 4);
#pragma unroll
        for (int ai = 0; ai < 2; ++ai)
#pragma unroll
            for (int mp = 0; mp < 2; ++mp) {
                f32x4 rv[2][2][2];
#pragma unroll
                for (int mm = 0; mm < 2; ++mm) { const size_t ro = (size_t)(row0 + ai * 128 + (2 * mp + mm) * 16) * DM + col0;
#pragma unroll
                    for (int bj = 0; bj < 2; ++bj)
#pragma unroll
                        for (int n = 0; n < 2; ++n) rv[mm][bj][n] = *(const f32x4*)(R + ro + bj * 128 + n * 4); }
#pragma unroll
                for (int mm = 0; mm < 2; ++mm) { const size_t ro = (size_t)(row0 + ai * 128 + (2 * mp + mm) * 16) * DM + col0;
#pragma unroll
                    for (int bj = 0; bj < 2; ++bj) { const f32x4 v0 = rv[mm][bj][0] + gv[bj][0] * acc[ai][bj][2 * mp + mm][0], v1 = rv[mm][bj][1] + gv[bj][1] * acc[ai][bj][2 * mp + mm][1];
                        u32x4 w; w.x = cvt_pk_bf16(v0[0], v0[1]); w.y = cvt_pk_bf16(v0[2], v0[3]); w.z = cvt_pk_bf16(v1[0], v1[1]); w.w = cvt_pk_bf16(v1[2], v1[3]);
                        *(u32x4*)(O + ro + bj * 128) = w; } }
            }
    }
};
struct EpiResidB2F {
    static constexpr bool PERM = true;
    const bf16_t* R; float* O; const float* gate;
    DI void operator()(const AccT& acc, const Unit& u, int wr, int wc, int fr, int fq) const {
        const int row0 = u.pm * 256 + wr * 64 + fr, col0 = u.pn * 256 + wc * 32 + 8 * fq;
        const int b = (u.pm * 256) >> 12;
        f32x4 gv[2][2];
#pragma unroll
        for (int bj = 0; bj < 2; ++bj)
#pragma unroll
            for (int n = 0; n < 2; ++n) gv[bj][n] = *(const f32x4*)(gate + (size_t)b * MODW + col0 + bj * 128 + n * 4);
#pragma unroll
        for (int ai = 0; ai < 2; ++ai) {
            u32x4 rb[4][2];
#pragma unroll
            for (int m = 0; m < 4; ++m) { const size_t ro = (size_t)(row0 + ai * 128 + m * 16) * DM + col0;
#pragma unroll
                for (int bj = 0; bj < 2; ++bj) rb[m][bj] = *(const u32x4*)(R + ro + bj * 128); }
#pragma unroll
            for (int m = 0; m < 4; ++m) { const size_t ro = (size_t)(row0 + ai * 128 + m * 16) * DM + col0;
#pragma unroll
                for (int bj = 0; bj < 2; ++bj) { const u32x4 t = rb[m][bj];
                    const f32x4 r0 = (f32x4){bf_lo(t.x), bf_hi(t.x), bf_lo(t.y), bf_hi(t.y)}, r1 = (f32x4){bf_lo(t.z), bf_hi(t.z), bf_lo(t.w), bf_hi(t.w)};
                    *(f32x4*)(O + ro + bj * 128) = r0 + gv[bj][0] * acc[ai][bj][m][0];
                    *(f32x4*)(O + ro + bj * 128 + 4) = r1 + gv[bj][1] * acc[ai][bj][m][1]; } }
        }
    }
};
struct EpiResidB2B {
    static constexpr bool PERM = true;
    const bf16_t* R; bf16_t* O; const float* gate;
    DI void operator()(const AccT& acc, const Unit& u, int wr, int wc, int fr, int fq) const {
        const int row0 = u.pm * 256 + wr * 64 + fr, col0 = u.pn * 256 + wc * 32 + 8 * fq;
        const int b = (u.pm * 256) >> 12;
        f32x4 gv[2][2];
#pragma unroll
        for (int bj = 0; bj < 2; ++bj)
#pragma unroll
            for (int n = 0; n < 2; ++n) gv[bj][n] = *(const f32x4*)(gate + (size_t)b * MODW + col0 + bj * 128 + n * 4);
#pragma unroll
        for (int ai = 0; ai < 2; ++ai) {
            u32x4 rb[4][2];
#pragma unroll
            for (int m = 0; m < 4; ++m) { const size_t ro = (size_t)(row0 + ai * 128 + m * 16) * DM + col0;
#pragma unroll
                for (int bj = 0; bj < 2; ++bj) rb[m][bj] = *(const u32x4*)(R + ro + bj * 128); }
#pragma unroll
            for (int m = 0; m < 4; ++m) { const size_t ro = (size_t)(row0 + ai * 128 + m * 16) * DM + col0;
#pragma unroll
                for (int bj = 0; bj < 2; ++bj) { const u32x4 t = rb[m][bj];
                    const f32x4 r0 = (f32x4){bf_lo(t.x), bf_hi(t.x), bf_lo(t.y), bf_hi(t.y)}, r1 = (f32x4){bf_lo(t.z), bf_hi(t.z), bf_lo(t.w), bf_hi(t.w)};
                    const f32x4 v0 = r0 + gv[bj][0] * acc[ai][bj][m][0], v1 = r1 + gv[bj][1] * acc[ai][bj][m][1];
                    u32x4 w; w.x = cvt_pk_bf16(v0[0], v0[1]); w.y = cvt_pk_bf16(v0[2], v0[3]); w.z = cvt_pk_bf16(v1[0], v1[1]); w.w = cvt_pk_bf16(v1[2], v1[3]);
                    *(u32x4*)(O + ro + bj * 128) = w; } }
        }
    }
};
struct EpiSwiGLU {
    static constexpr bool PERM = true;
    bf16_t* O;
    DI void operator()(const AccT& acc, const Unit& u, int wr, int wc, int fr, int fq) const {
        const int row0 = u.pm * 256 + wr * 64 + fr, col0 = u.pn * 128 + wc * 32 + 8 * fq;
#pragma unroll
        for (int ai = 0; ai < 2; ++ai)
#pragma unroll
            for (int m = 0; m < 4; ++m) { bf16_t* rowp = O + (size_t)(row0 + ai * 128 + m * 16) * DFF + col0;
                float r[8];
#pragma unroll
                for (int n = 0; n < 2; ++n)
#pragma unroll
                    for (int e = 0; e < 4; ++e) r[n * 4 + e] = silu_f(acc[ai][0][m][n][e]) * acc[ai][1][m][n][e];
                u32x4 w; w.x = cvt_pk_bf16(r[0], r[1]); w.y = cvt_pk_bf16(r[2], r[3]); w.z = cvt_pk_bf16(r[4], r[5]); w.w = cvt_pk_bf16(r[6], r[7]);
                *(u32x4*)rowp = w; }
    }
};
struct EpiRetQKV {
    static constexpr bool PERM = true;
    bf16_t *Q, *Kt, *V; const float *cosT, *sinT;
    DI void operator()(const AccT& acc, const Unit& u, int wr, int wc, int fr, int fq) const {
        const int row0 = u.pm * 256 + wr * 64 + fr, i0 = wc * 32 + 8 * fq;
        if (u.pn >= 16) {
#pragma unroll
            for (int ai = 0; ai < 2; ++ai)
#pragma unroll
                for (int m = 0; m < 4; ++m) { bf16_t* rowp = V + (size_t)(row0 + ai * 128 + m * 16) * 4096 + (u.pn - 16) * 256 + i0;
#pragma unroll
                    for (int bj = 0; bj < 2; ++bj) { const f32x4 v0 = acc[ai][bj][m][0], v1 = acc[ai][bj][m][1];
                        u32x4 w; w.x = cvt_pk_bf16(v0[0], v0[1]); w.y = cvt_pk_bf16(v0[2], v0[3]); w.z = cvt_pk_bf16(v1[0], v1[1]); w.w = cvt_pk_bf16(v1[2], v1[3]);
                        *(u32x4*)(rowp + bj * 128) = w; } }
            return;
        }
        const bool isk = u.pn >= 8; const int hd = u.pn & 7;
        bf16_t* dst = (isk ? Kt : Q) + hd * 256 + i0;
        const float l2g = __log2f(1.0f - exp2f(-5.0f - (float)hd));
#pragma unroll
        for (int ai = 0; ai < 2; ++ai) {
            f32x4 cvs[4][2], svs[4][2];
#pragma unroll
            for (int m = 0; m < 4; ++m) { const int s = (row0 + ai * 128 + m * 16) & 4095;
#pragma unroll
                for (int n = 0; n < 2; ++n) { cvs[m][n] = *(const f32x4*)(cosT + s * 128 + i0 + n * 4); svs[m][n] = *(const f32x4*)(sinT + s * 128 + i0 + n * 4); } }
#pragma unroll
            for (int m = 0; m < 4; ++m) { const int row = row0 + ai * 128 + m * 16; const int s = row & 4095;
                const float sc = isk ? 0.0625f * exp2f(-(float)((s & 127) + 1) * l2g) : 1.0f;
                float o1[8], o2[8];
#pragma unroll
                for (int n = 0; n < 2; ++n) { const f32x4 cv = cvs[m][n], sv = svs[m][n];
                    const f32x4 t1 = acc[ai][0][m][n], t2 = acc[ai][1][m][n];
#pragma unroll
                    for (int e = 0; e < 4; ++e) { o1[n * 4 + e] = (t1[e] * cv[e] - t2[e] * sv[e]) * sc; o2[n * 4 + e] = (t1[e] * sv[e] + t2[e] * cv[e]) * sc; } }
                u32x4 w1, w2;
                w1.x = cvt_pk_bf16(o1[0], o1[1]); w1.y = cvt_pk_bf16(o1[2], o1[3]); w1.z = cvt_pk_bf16(o1[4], o1[5]); w1.w = cvt_pk_bf16(o1[6], o1[7]);
                w2.x = cvt_pk_bf16(o2[0], o2[1]); w2.y = cvt_pk_bf16(o2[2], o2[3]); w2.z = cvt_pk_bf16(o2[4], o2[5]); w2.w = cvt_pk_bf16(o2[6], o2[7]);
                bf16_t* rp = dst + (size_t)row * 2048;
                *(u32x4*)rp = w1; *(u32x4*)(rp + 128) = w2; }
        }
    }
};
struct EpiRetGate {
    static constexpr bool PERM = true;
    bf16_t* RO; const float* ssq;
    DI void operator()(const AccT& acc, const Unit& u, int wr, int wc, int fr, int fq) const {
        const int row0 = u.pm * 256 + wr * 64 + fr, col0 = u.pn * 256 + wc * 32 + 8 * fq, hd = u.pn >> 1;
#pragma unroll
        for (int ai = 0; ai < 2; ++ai) {
            f32x4 sq[4]; u32x4 ov[4][2];
#pragma unroll
            for (int m = 0; m < 4; ++m) { const int row = row0 + ai * 128 + m * 16; sq[m] = *(const f32x4*)(ssq + (size_t)row * 32 + hd * 4);
                const bf16_t* rowp = RO + (size_t)row * 4096 + col0; ov[m][0] = *(const u32x4*)rowp; ov[m][1] = *(const u32x4*)(rowp + 128); }
#pragma unroll
            for (int m = 0; m < 4; ++m) { const int row = row0 + ai * 128 + m * 16;
                const float rn = rsqrtf((sq[m][0] + sq[m][1] + sq[m][2] + sq[m][3]) * (1.0f / 512.0f) + NEPS);
                bf16_t* rowp = RO + (size_t)row * 4096 + col0;
#pragma unroll
                for (int bj = 0; bj < 2; ++bj) { const u32x4 o = ov[m][bj];
                    const f32x4 g0 = acc[ai][bj][m][0], g1 = acc[ai][bj][m][1];
                    u32x4 w;
                    w.x = cvt_pk_bf16(silu_f(g0[0]) * bf_lo(o.x) * rn, silu_f(g0[1]) * bf_hi(o.x) * rn);
                    w.y = cvt_pk_bf16(silu_f(g0[2]) * bf_lo(o.y) * rn, silu_f(g0[3]) * bf_hi(o.y) * rn);
                    w.z = cvt_pk_bf16(silu_f(g1[0]) * bf_lo(o.z) * rn, silu_f(g1[1]) * bf_hi(o.z) * rn);
                    w.w = cvt_pk_bf16(silu_f(g1[2]) * bf_lo(o.w) * rn, silu_f(g1[3]) * bf_hi(o.w) * rn);
                    *(u32x4*)(rowp + bj * 128) = w; } }
        }
    }
};

struct CJob { const float* src; bf16_t* dst; int ldsrc, K, nrows, mode, coff; };
DI void convert_w(const CJob j, LAS unsigned* lw) {
    const int tid = tidx(), ntR = j.nrows >> 6, ntK = j.K >> 7, total = ntR * ntK;
    const int nq = tid & 15, kr = tid >> 4;
    auto tile_src = [&](int tile) -> const float* { const int rt = tile % ntR, kt = tile / ntR, R0 = rt * 64, k0 = kt * 128;
        const int c0 = j.mode == 0 ? j.coff + R0 : ((R0 >> 7) & 1) * DFF + (R0 >> 8) * 128 + (R0 & 127);
        return j.src + (size_t)(k0 + 2 * kr) * j.ldsrc + c0 + 4 * nq; };
    f32x4 a[2][2], an[2][2];
    int tile = bidx();
    if (tile < total) { const float* sp = tile_src(tile);
#pragma unroll
        for (int p = 0; p < 2; ++p) { const float* s = sp + (size_t)(64 * p) * j.ldsrc; a[p][0] = *(const f32x4*)s; a[p][1] = *(const f32x4*)(s + j.ldsrc); } }
    for (; tile < total; tile += gridDim.x) {
        const int rt = tile % ntR, kt = tile / ntR, R0 = rt * 64, k0 = kt * 128;
        { const int tnext = tile + gridDim.x; const float* sp = tile_src(tnext < total ? tnext : tile);
#pragma unroll
            for (int p = 0; p < 2; ++p) { const float* s = sp + (size_t)(64 * p) * j.ldsrc; an[p][0] = *(const f32x4*)s; an[p][1] = *(const f32x4*)(s + j.ldsrc); } }
#pragma unroll
        for (int p = 0; p < 2; ++p) { const int kp = p * 32 + kr;
#pragma unroll
            for (int e = 0; e < 4; ++e) lw[(4 * nq + e) * 65 + kp] = cvt_pk_bf16(a[p][0][e], a[p][1][e]); }
        __syncthreads();
#pragma unroll
        for (int i = 0; i < 2; ++i) { const int idx = tid + 512 * i, n = idx >> 4, ch = idx & 15;
            u32x4 v; v.x = lw[n * 65 + 4 * ch]; v.y = lw[n * 65 + 4 * ch + 1]; v.z = lw[n * 65 + 4 * ch + 2]; v.w = lw[n * 65 + 4 * ch + 3];
            *(u32x4*)(j.dst + (size_t)(R0 + n) * j.K + k0 + 8 * ch) = v; }
        __syncthreads();
#pragma unroll
        for (int p = 0; p < 2; ++p) { a[p][0] = an[p][0]; a[p][1] = an[p][1]; }
    }
}
DI void convert_set(const Params& P, int set, LAS unsigned* lw) {
    const int njobs = set == 0 ? 4 : (set == 1 ? 3 : 2);
    for (int ji = 0; ji < njobs; ++ji) {
        CJob j;
        const int id = set * 4 + ji;
        switch (id) {
            case 0:  j = CJob{P.att_w_qkv, (bf16_t*)(P.ws + OFF_WQKV0), 18432, 2048, 18432, 0, 0}; break;
            case 1:  j = CJob{P.att_w_o, (bf16_t*)(P.ws + OFF_WO0), 2048, 2048, 2048, 0, 0}; break;
            case 2:  j = CJob{P.ffn_w_up, (bf16_t*)(P.ws + OFF_WUP0), 11264, 2048, 11264, 1, 0}; break;
            case 3:  j = CJob{P.ffn_w_down, (bf16_t*)(P.ws + OFF_WDN0), 2048, 5632, 2048, 0, 0}; break;
            case 4:  j = CJob{P.ret_w_qkvg, (bf16_t*)(P.ws + OFF_WRQKV), 12288, 2048, 8192, 0, 0}; break;
            case 5:  j = CJob{P.ret_w_qkvg, (bf16_t*)(P.ws + OFF_WRG), 12288, 2048, 4096, 0, 8192}; break;
            case 6:  j = CJob{P.ret_w_o, (bf16_t*)(P.ws + OFF_WRO), 2048, 4096, 2048, 0, 0}; break;
            case 8:  j = CJob{P.ffn_w_up + (size_t)2048 * 11264, (bf16_t*)(P.ws + OFF_WUP1), 11264, 2048, 11264, 1, 0}; break;
            default: j = CJob{P.ffn_w_down + (size_t)5632 * 2048, (bf16_t*)(P.ws + OFF_WDN1), 2048, 5632, 2048, 0, 0}; break;
        }
        convert_w(j, lw);
    }
}

DI void mod_gemv(const Params& P, LAS float* lf) {
    const int tid = tidx();
    if (bidx() >= 192) return;
    for (int i = tid; i < 8 * 2048; i += NTHREADS) lf[i] = silu_f(P.c[i]);
    __syncthreads();
    LAS float* red = lf + 16384;
    float* mod = (float*)(P.ws + OFF_MOD);
    const int cq = tid & 31, kg = tid >> 5;
    for (int item = bidx(); item < 192; item += gridDim.x) {
        const int l = item / 96, nb = item % 96;
        const float* w = P.w_mod + ((size_t)l * 2048 + kg * 128) * MODW + nb * 128 + cq * 4;
        f32x4 acc[8];
#pragma unroll
        for (int b = 0; b < 8; ++b) acc[b] = (f32x4){0.f, 0.f, 0.f, 0.f};
        const LAS float* cs = lf + kg * 128;
#pragma unroll 1
        for (int k0 = 0; k0 < 128; k0 += 8) {
            f32x4 wv[8];
#pragma unroll
            for (int kk = 0; kk < 8; ++kk) wv[kk] = *(const f32x4*)(w + (size_t)(k0 + kk) * MODW);
#pragma unroll
            for (int kk = 0; kk < 8; ++kk)
#pragma unroll
                for (int b = 0; b < 8; ++b) acc[b] += wv[kk] * cs[b * 2048 + k0 + kk];
        }
#pragma unroll
        for (int b = 0; b < 8; ++b) *(LAS f32x4*)(red + (kg * 8 + b) * 128 + cq * 4) = acc[b];
        __syncthreads();
        for (int i = tid; i < 1024; i += NTHREADS) { const int b = i >> 7, cc = i & 127;
            float sum = 0.f;
#pragma unroll
            for (int g = 0; g < 16; ++g) sum += red[(g * 8 + b) * 128 + cc];
            mod[(size_t)(l * 8 + b) * MODW + nb * 128 + cc] = sum + P.b_mod[l * MODW + nb * 128 + cc]; }
        __syncthreads();
    }
}
DI void rotary_tables(const Params& P) {
    float* cosT = (float*)(P.ws + OFF_COS); float* sinT = (float*)(P.ws + OFF_SIN);
    for (int i = bidx() * NTHREADS + tidx(); i < 4096 * 128; i += gridDim.x * NTHREADS) {
        const int s = i >> 7, jx = i & 127;
        const float inv = 1.0f / exp2f((float)jx * (13.287712379549449f / 127.0f));
        const float ang = (float)s * inv;
        const float nn = rintf(ang * 0.15915494309189535f);
        float r = fmaf(-nn, 6.2831854820251465f, ang); r = fmaf(-nn, -1.7484555e-07f, r);
        cosT[i] = __cosf(r); sinT[i] = __sinf(r);
    }
}

template <bool SRCBF> DI void norm_phase(const Params& P, int l, int which) {
    const float* src = (l == 0 && which == 0) ? P.x : P.out;
    const bf16_t* srcb = which ? (const bf16_t*)(P.ws + (l == 0 ? OFF_XB1 : OFF_XB3)) : (const bf16_t*)P.out;
    const float* gain = (which ? P.norm_ffn : P.norm_mix) + l * DM;
    const float* mod = (const float*)(P.ws + OFF_MOD) + (size_t)l * 8 * MODW;
    bf16_t* H = (bf16_t*)(P.ws + OFF_H);
    const int lane = tidx() & 63, gw = bidx() * 8 + (tidx() >> 6), nw = gridDim.x * 8;
    for (int blk = gw; blk < TTOK / 16; blk += nw) {
        const int rbase = blk * 16, b = rbase >> 12;
        const float* sh = mod + (size_t)b * MODW + (which ? 3 : 0) * DM; const float* sc = mod + (size_t)b * MODW + (which ? 4 : 1) * DM;
        f32x4 av[8], hv[8];
#pragma unroll
        for (int i = 0; i < 8; ++i) { const int cc = 4 * lane + 256 * i; const f32x4 gv = *(const f32x4*)(gain + cc), sv = *(const f32x4*)(sc + cc); hv[i] = *(const f32x4*)(sh + cc);
#pragma unroll
            for (int e = 0; e < 4; ++e) av[i][e] = gv[e] * (1.0f + sv[e]); }
#pragma unroll 1
        for (int rp = 0; rp < 8; ++rp) {
            const int row0 = rbase + 2 * rp;
            f32x4 v[2][8]; float ss0 = 0.f, ss1 = 0.f;
            if constexpr (SRCBF) { const bf16_t* xb = srcb + (size_t)row0 * DM;
#pragma unroll
                for (int i = 0; i < 8; ++i) { const u32x2 t0 = *(const u32x2*)(xb + 4 * lane + 256 * i), t1 = *(const u32x2*)(xb + DM + 4 * lane + 256 * i);
                    v[0][i] = (f32x4){bf_lo(t0.x), bf_hi(t0.x), bf_lo(t0.y), bf_hi(t0.y)}; v[1][i] = (f32x4){bf_lo(t1.x), bf_hi(t1.x), bf_lo(t1.y), bf_hi(t1.y)}; } }
            else { const float* xr = src + (size_t)row0 * DM;
#pragma unroll
                for (int i = 0; i < 8; ++i) { v[0][i] = *(const f32x4*)(xr + 4 * lane + 256 * i); v[1][i] = *(const f32x4*)(xr + DM + 4 * lane + 256 * i); } }
#pragma unroll
            for (int i = 0; i < 8; ++i) { ss0 += v[0][i][0] * v[0][i][0] + v[0][i][1] * v[0][i][1] + v[0][i][2] * v[0][i][2] + v[0][i][3] * v[0][i][3];
                ss1 += v[1][i][0] * v[1][i][0] + v[1][i][1] * v[1][i][1] + v[1][i][2] * v[1][i][2] + v[1][i][3] * v[1][i][3]; }
            ss0 += shx(ss0, 1); ss1 += shx(ss1, 1); ss0 += shx(ss0, 2); ss1 += shx(ss1, 2); ss0 += shx(ss0, 4); ss1 += shx(ss1, 4);
            ss0 += shx(ss0, 8); ss1 += shx(ss1, 8); ss0 += shx(ss0, 16); ss1 += shx(ss1, 16); ss0 += shx(ss0, 32); ss1 += shx(ss1, 32);
            const float rs0 = rsqrtf(ss0 * (1.0f / 2048.0f) + NEPS), rs1 = rsqrtf(ss1 * (1.0f / 2048.0f) + NEPS);
            bf16_t* hr = H + (size_t)row0 * DM;
#pragma unroll
            for (int i = 0; i < 8; ++i) { const int cc = 4 * lane + 256 * i;
                f32x4 o0, o1;
#pragma unroll
                for (int e = 0; e < 4; ++e) { o0[e] = v[0][i][e] * rs0 * av[i][e] + hv[i][e]; o1[e] = v[1][i][e] * rs1 * av[i][e] + hv[i][e]; }
                u32x2 w0, w1; w0.x = cvt_pk_bf16(o0[0], o0[1]); w0.y = cvt_pk_bf16(o0[2], o0[3]); w1.x = cvt_pk_bf16(o1[0], o1[1]); w1.y = cvt_pk_bf16(o1[2], o1[3]);
                *(u32x2*)(hr + cc) = w0; *(u32x2*)(hr + DM + cc) = w1; }
        }
    }
}
DI int t5_bucket(int dist) {
    if (dist < 16) return dist;
    const float v = logf((float)dist / 16.0f) / 4.852030263919617f * 16.0f;
    const int lg = 16 + (int)v;
    return lg < 31 ? lg : 31;
}
#define MFMA16(a, b, c) __builtin_amdgcn_mfma_f32_16x16x32_bf16((a), (b), (c), 0, 0, 0)
DI bf16x8 gather_col(const LAS unsigned char* p0, const LAS unsigned char* p1, int stride) {
    bf16x8 r;
    r[0] = *(const LAS short*)(p0); r[1] = *(const LAS short*)(p0 + stride); r[2] = *(const LAS short*)(p0 + 2 * stride); r[3] = *(const LAS short*)(p0 + 3 * stride);
    r[4] = *(const LAS short*)(p1); r[5] = *(const LAS short*)(p1 + stride); r[6] = *(const LAS short*)(p1 + 2 * stride); r[7] = *(const LAS short*)(p1 + 3 * stride);
    return r;
}
typedef short s16x4 __attribute__((ext_vector_type(4)));
DI bf16x8 tr_frag(const LAS unsigned char* p0, const LAS unsigned char* p1) {
    const s16x4 lo = __builtin_amdgcn_ds_read_tr16_b64_v4i16((LAS s16x4*)p0), hi = __builtin_amdgcn_ds_read_tr16_b64_v4i16((LAS s16x4*)p1);
    return __builtin_shufflevector(lo, hi, 0, 1, 2, 3, 4, 5, 6, 7);
}
DI bf16x8 pack8(const float* f) { u32x4 w; w.x = cvt_pk_bf16(f[0], f[1]); w.y = cvt_pk_bf16(f[2], f[3]); w.z = cvt_pk_bf16(f[4], f[5]); w.w = cvt_pk_bf16(f[6], f[7]); return __builtin_bit_cast(bf16x8, w); }

#define ATT_RAW_BAR() do { asm volatile("s_waitcnt lgkmcnt(0)" ::: "memory"); __builtin_amdgcn_s_barrier(); asm volatile("" ::: "memory"); } while (0)
DI void attn_phase(const Params& P, LAS unsigned char* L) {
    const bf16_t* QKV = (const bf16_t*)(P.ws + OFF_QKVC);
    bf16_t* OG = (bf16_t*)(P.ws + OFF_OG); float* LSE = (float*)(P.ws + OFF_LSE);
    const int tid = tidx(), lane = tid & 63, w = __builtin_amdgcn_readfirstlane(tid >> 6), fr = lane & 15, fq = lane >> 4;
    LAS unsigned char* Ks = L; LAS unsigned char* Vs = L + 65536; LAS float* biasL = (LAS float*)(L + 131072);
    const int ch = tid & 15, krow = tid >> 4;
    int vtr[8];
#pragma unroll
    for (int dt = 0; dt < 8; ++dt) vtr[dt] = (4 * fq + (fr >> 2)) * 256 + ((dt ^ (4 * (fq & 1) + (fr >> 2))) << 5) + (fr & 3) * 8;
    for (int sg = bidx(); sg < 768; sg += gridDim.x) {
        const int it0 = sg * 4;
        const int blk0 = it0 & 31, h = (it0 >> 5) & 15, gb = it0 >> 9, g = gb % 3, bb = gb / 3;
        const int l2d = 2 * g, dil = 1 << l2d, nbl2 = 5 - l2d, nbm = (32 >> l2d) - 1;
        const size_t rowbase = (size_t)bb * 4096;
        const int colq = g * 6144 + h * 128;
        const bf16_t* qkv_c = QKV + ((size_t)(g * 24 + (h >> 1)) * 8192) * 256 + (h & 1) * 128;
        constexpr size_t TILE8 = (size_t)8 * 8192 * 256;
        const f32x4 kg0 = *(const f32x4*)(P.att_k_gain + g * 128 + ch * 8), kg1 = *(const f32x4*)(P.att_k_gain + g * 128 + ch * 8 + 4);
        u32x4 ka[4], va[4], qraw[4], qnext[4];
        auto load_block = [&](int r_, int n_) {
#pragma unroll
            for (int i = 0; i < 4; ++i) { const int idx = n_ * 128 + krow + 32 * i;
                const bf16_t* p = qkv_c + (rowbase + (size_t)idx * dil + r_) * 256 + ch * 8; ka[i] = *(const u32x4*)(p + TILE8); va[i] = *(const u32x4*)(p + 2 * TILE8); } };
        auto stage_block = [&](int half) {
#pragma unroll
            for (int i = 0; i < 4; ++i) { const int row = half * 128 + krow + 32 * i; const u32x4 kv = ka[i];
                float f[8] = {bf_lo(kv.x), bf_hi(kv.x), bf_lo(kv.y), bf_hi(kv.y), bf_lo(kv.z), bf_hi(kv.z), bf_lo(kv.w), bf_hi(kv.w)};
                float ss = 0.f;
#pragma unroll
                for (int e = 0; e < 8; ++e) ss += f[e] * f[e];
                ss += shx(ss, 1); ss += shx(ss, 2); ss += shx(ss, 4); ss += shx(ss, 8);
                const float rk = rsqrtf(ss * (1.0f / 128.0f) + NEPS);
#pragma unroll
                for (int e = 0; e < 4; ++e) { f[e] *= rk * kg0[e]; f[4 + e] *= rk * kg1[e]; }
                *(LAS bf16x8*)(Ks + row * 256 + ((ch ^ (row & 15)) << 4)) = pack8(f);
                *(LAS u32x4*)(Vs + row * 256 + (((ch >> 1) ^ (row & 7)) << 5) + (ch & 1) * 16) = va[i]; } };
        auto load_q = [&](int r_, int n_, u32x4* dst) {
            const size_t qrow_ = rowbase + (size_t)(n_ * 128 + 16 * w + fr) * dil + r_;
            const bf16_t* qp = qkv_c + qrow_ * 256 + 8 * fq;
#pragma unroll
            for (int ks = 0; ks < 4; ++ks) dst[ks] = *(const u32x4*)(qp + 32 * ks); };
        const int r0 = blk0 >> nbl2, n0 = blk0 & nbm;
        if (tid < 129) { const int bk = t5_bucket(tid * dil); biasL[tid] = P.rel_bias[bk * 48 + g * 16 + h] * LOG2E; }
        if (tid >= 256 && tid < 384) biasL[132 + tid - 256] = P.att_q_gain[g * 128 + tid - 256];
        if (n0 > 0) { load_block(r0, n0 - 1); stage_block((n0 - 1) & 1); }
        else {
#pragma unroll
            for (int i = 0; i < 4; ++i) { const int row = 128 + krow + 32 * i; *(LAS u32x4*)(Ks + row * 256 + ch * 16) = (u32x4){0u, 0u, 0u, 0u}; *(LAS u32x4*)(Vs + row * 256 + ch * 16) = (u32x4){0u, 0u, 0u, 0u}; } }
        load_block(r0, n0); stage_block(n0 & 1);
        load_q(r0, n0, qraw);
        __syncthreads();
#pragma unroll 1
        for (int i4 = 0; i4 < 4; ++i4) {
            const int blk = blk0 + i4, r = blk >> nbl2, n = blk & nbm;
            const int blkn = blk + 1, rn = blkn >> nbl2, nn = blkn & nbm;
            const size_t qrow = rowbase + (size_t)(n * 128 + 16 * w + fr) * dil + r;
            bf16x8 qf[4];
            {
                float ss = 0.f;
#pragma unroll
                for (int ks = 0; ks < 4; ++ks) {
                    const float f[8] = {bf_lo(qraw[ks].x), bf_hi(qraw[ks].x), bf_lo(qraw[ks].y), bf_hi(qraw[ks].y), bf_lo(qraw[ks].z), bf_hi(qraw[ks].z), bf_lo(qraw[ks].w), bf_hi(qraw[ks].w)};
#pragma unroll
                    for (int e = 0; e < 8; ++e) ss += f[e] * f[e]; }
                ss += shx(ss, 16); ss += shx(ss, 32);
                const float rq = rsqrtf(ss * (1.0f / 128.0f) + NEPS) * (0.08838834764831845f * LOG2E);
#pragma unroll
                for (int ks = 0; ks < 4; ++ks) { const LAS float* gp = biasL + 132 + 32 * ks + 8 * fq; const f32x4 g0 = *(const LAS f32x4*)gp, g1 = *(const LAS f32x4*)(gp + 4);
                    float f[8] = {bf_lo(qraw[ks].x), bf_hi(qraw[ks].x), bf_lo(qraw[ks].y), bf_hi(qraw[ks].y), bf_lo(qraw[ks].z), bf_hi(qraw[ks].z), bf_lo(qraw[ks].w), bf_hi(qraw[ks].w)};
#pragma unroll
                    for (int e = 0; e < 4; ++e) { f[e] *= rq * g0[e]; f[4 + e] *= rq * g1[e]; }
                    qf[ks] = pack8(f); }
            }
            if (i4 < 3) { load_block(rn, nn); load_q(rn, nn, qnext); }
            f32x4 sc[9];
            {
                bf16x8 kfa[2][4];
                auto load_kf = [&](int tt, bf16x8* dst) { const int t = w + tt; const int row = (((n + 1 + (t >> 3)) & 1) << 7) + ((t & 7) << 4) + fr;
#pragma unroll
                    for (int ks = 0; ks < 4; ++ks) dst[ks] = *(const LAS bf16x8*)(Ks + row * 256 + (((4 * ks + fq) ^ fr) << 4)); };
                load_kf(0, kfa[0]);
#pragma unroll
                for (int tt = 0; tt < 9; ++tt) {
                    if (tt + 1 < 9) load_kf(tt + 1, kfa[(tt + 1) & 1]);
                    __builtin_amdgcn_sched_barrier(0);
                    f32x4 a = (f32x4){0.f, 0.f, 0.f, 0.f};
#pragma unroll
                    for (int ks = 0; ks < 4; ++ks) a = MFMA16(kfa[tt & 1][ks], qf[ks], a);
                    sc[tt] = a;
                    __builtin_amdgcn_sched_barrier(0);
                }
            }
            float mx = -3.0e38f;
#pragma unroll
            for (int tt = 0; tt < 9; ++tt)
#pragma unroll
                for (int j = 0; j < 4; ++j) { const int delta = 128 + fr - 16 * tt - 4 * fq - j; const int ki = 16 * (w + tt) + 4 * fq + j;
                    const bool valid = (delta >= 0) && (delta <= 128) && (n > 0 || ki >= 128);
                    const int dc = delta < 0 ? 0 : (delta > 128 ? 128 : delta);
                    const float s = valid ? sc[tt][j] + biasL[dc] : -1.0e30f;
                    sc[tt][j] = s; mx = fmaxf(mx, s); }
            mx = fmaxf(mx, shx(mx, 16)); mx = fmaxf(mx, shx(mx, 32));
            float sum = 0.f;
#pragma unroll
            for (int tt = 0; tt < 9; ++tt)
#pragma unroll
                for (int j = 0; j < 4; ++j) { const float p = __builtin_amdgcn_exp2f(sc[tt][j] - mx); sc[tt][j] = p; sum += p; }
            sum += shx(sum, 16); sum += shx(sum, 32);
            f32x4 oacc[8];
#pragma unroll
            for (int dt = 0; dt < 8; ++dt) oacc[dt] = (f32x4){0.f, 0.f, 0.f, 0.f};
            bf16x8 pb[5];
#pragma unroll
            for (int s2 = 0; s2 < 5; ++s2) { float pf[8];
#pragma unroll
                for (int j = 0; j < 4; ++j) { pf[j] = sc[2 * s2][j]; pf[4 + j] = (2 * s2 + 1 <= 8) ? sc[(2 * s2 + 1 <= 8) ? 2 * s2 + 1 : 8][j] : 0.f; }
                pb[s2] = pack8(pf); }
            {
                bf16x8 vfa[2][2];
                auto load_vf = [&](int hb, bf16x8* dst) { const int s2 = hb >> 2, dh = (hb & 3) * 2;
                    const int t0 = w + 2 * s2; int t1 = w + 2 * s2 + 1; t1 = t1 > 15 ? 15 : t1;
                    const int rw0 = (((n + 1 + (t0 >> 3)) & 1) << 7) + ((t0 & 7) << 4), rw1 = (((n + 1 + (t1 >> 3)) & 1) << 7) + ((t1 & 7) << 4);
                    const LAS unsigned char* v0 = Vs + rw0 * 256; const LAS unsigned char* v1 = Vs + rw1 * 256;
#pragma unroll
                    for (int d = 0; d < 2; ++d) dst[d] = tr_frag(v0 + vtr[dh + d], v1 + vtr[dh + d]); };
                load_vf(0, vfa[0]);
#pragma unroll
                for (int hb = 0; hb < 20; ++hb) {
                    if (hb + 1 < 20) load_vf(hb + 1, vfa[(hb + 1) & 1]);
                    __builtin_amdgcn_sched_barrier(0);
#pragma unroll
                    for (int d = 0; d < 2; ++d) oacc[(hb & 3) * 2 + d] = MFMA16(vfa[hb & 1][d], pb[hb >> 2], oacc[(hb & 3) * 2 + d]);
                    __builtin_amdgcn_sched_barrier(0);
                }
            }
            const float inv = 1.0f / sum;
            bf16_t* op = OG + ((size_t)g * 8192 + qrow) * 2048 + h * 128 + 4 * fq;
#pragma unroll
            for (int dt = 0; dt < 8; ++dt) { u32x2 wv; wv.x = cvt_pk_bf16(oacc[dt][0] * inv, oacc[dt][1] * inv); wv.y = cvt_pk_bf16(oacc[dt][2] * inv, oacc[dt][3] * inv); *(u32x2*)(op + 16 * dt) = wv; }
            if (fq == 0) LSE[((size_t)g * 8192 + qrow) * 16 + h] = mx + __log2f(sum);
            ATT_RAW_BAR();
            if (i4 < 3) { stage_block(nn & 1);
#pragma unroll
                for (int ks = 0; ks < 4; ++ks) qraw[ks] = qnext[ks]; }
            ATT_RAW_BAR();
        }
    }
}
DI void merge_phase(const Params& P, int cb) {
    const bf16_t* OG = (const bf16_t*)(P.ws + OFF_OG); const float* LSE = (const float*)(P.ws + OFF_LSE);
    bf16_t* O = (bf16_t*)(P.ws + OFF_O) + (size_t)cb * 8192 * 2048;
    const int tid = tidx();
    const int c8 = (tid & 255) * 8, h = c8 >> 7;
    for (int pr0 = bidx() * 4; pr0 < 4096; pr0 += gridDim.x * 4) {
        float l[4][3]; u32x4 a[4][3];
#pragma unroll
        for (int q = 0; q < 4; ++q) { const int tok = (pr0 + q) * 2 + (tid >> 8);
#pragma unroll
            for (int g = 0; g < 3; ++g) { l[q][g] = LSE[((size_t)g * 8192 + tok) * 16 + h]; a[q][g] = *(const u32x4*)(OG + ((size_t)g * 8192 + tok) * 2048 + c8); } }
#pragma unroll
        for (int q = 0; q < 4; ++q) { const int tok = (pr0 + q) * 2 + (tid >> 8);
            const float m = fmaxf(l[q][0], fmaxf(l[q][1], l[q][2]));
            float w0 = __builtin_amdgcn_exp2f(l[q][0] - m), w1 = __builtin_amdgcn_exp2f(l[q][1] - m), w2 = __builtin_amdgcn_exp2f(l[q][2] - m);
            const float inv = 1.0f / (w0 + w1 + w2); w0 *= inv; w1 *= inv; w2 *= inv;
            const u32x4 x = a[q][0], y = a[q][1], z = a[q][2];
            u32x4 o;
            o.x = cvt_pk_bf16(w0 * bf_lo(x.x) + w1 * bf_lo(y.x) + w2 * bf_lo(z.x), w0 * bf_hi(x.x) + w1 * bf_hi(y.x) + w2 * bf_hi(z.x));
            o.y = cvt_pk_bf16(w0 * bf_lo(x.y) + w1 * bf_lo(y.y) + w2 * bf_lo(z.y), w0 * bf_hi(x.y) + w1 * bf_hi(y.y) + w2 * bf_hi(z.y));
            o.z = cvt_pk_bf16(w0 * bf_lo(x.z) + w1 * bf_lo(y.z) + w2 * bf_lo(z.z), w0 * bf_hi(x.z) + w1 * bf_hi(y.z) + w2 * bf_hi(z.z));
            o.w = cvt_pk_bf16(w0 * bf_lo(x.w) + w1 * bf_lo(y.w) + w2 * bf_lo(z.w), w0 * bf_hi(x.w) + w1 * bf_hi(y.w) + w2 * bf_hi(z.w));
            *(u32x4*)(O + (size_t)tok * 2048 + c8) = o; }
    }
}
DI int swz32(int chunk, int row) { return (((chunk & 15) ^ (row & 15)) | (chunk & 16)) << 4; }
#define RAW_BAR() do { asm volatile("s_waitcnt lgkmcnt(0)" ::: "memory"); __builtin_amdgcn_s_barrier(); asm volatile("" ::: "memory"); } while (0)
DI void scan_phase(const Params& P, LAS unsigned char* L) {
    const bf16_t* RQ = (const bf16_t*)(P.ws + OFF_RQ); const bf16_t* RK = (const bf16_t*)(P.ws + OFF_RK); const bf16_t* RV = (const bf16_t*)(P.ws + OFF_RV);
    bf16_t* RO = (bf16_t*)(P.ws + OFF_RO); float* SSQ = (float*)(P.ws + OFF_SSQ);
    const int tid = tidx(), lane = tid & 63, w = __builtin_amdgcn_readfirstlane(tid >> 6), fr = lane & 15, fq = lane >> 4;
    LAS unsigned char* S = L; LAS unsigned char* Kb = L + 65536; LAS unsigned char* Vs = L + 131072;
    int xb[4], ktr[2], wb[2], vtr[8];
    const int q4 = fr >> 2, p4 = fr & 3;
#pragma unroll
    for (int a = 0; a < 4; ++a) xb[a] = fr * 512 + (((4 * a + fq) ^ fr) << 4);
#pragma unroll
    for (int a = 0; a < 2; ++a) {
        ktr[a] = (4 * fq + q4) * 512 + ((((4 * w + 2 * a + (p4 >> 1)) & 15) ^ (4 * fq + q4)) << 4) + ((w >> 2) << 8) + (p4 & 1) * 8;
        wb[a] = fr * 512 + ((((4 * w + 2 * a + (fq >> 1)) & 15) ^ fr) << 4) + ((w >> 2) << 8) + (fq & 1) * 8; }
#pragma unroll
    for (int vt = 0; vt < 8; ++vt) vtr[vt] = (4 * fq + q4) * 256 + ((vt ^ (4 * (fq & 1) + q4)) << 5) + p4 * 8;
    const int km = lane >> 5, kcp = lane & 31;
    const int vm = lane >> 4, vcp = lane & 15;
    const unsigned kgo = (unsigned)(km * 2048 + ((kcp & 16) | ((kcp & 15) ^ ((2 * w + km) & 15))) * 8);
    const unsigned vgo = (unsigned)(vm * 4096 + ((((vcp >> 1) ^ ((4 * w + vm) & 7)) << 1) | (vcp & 1)) * 8);
    for (int it = bidx(); it < 256; it += gridDim.x) {
        const int vs = it & 3, h = (it >> 2) & 7, b = it >> 5;
        const float l2g = __log2f(1.0f - exp2f(-5.0f - (float)h));
        const float gC = exp2f(128.0f * l2g);
        f32x4 sacc[2][8];
#pragma unroll
        for (int a = 0; a < 2; ++a)
#pragma unroll
            for (int v = 0; v < 8; ++v) sacc[a][v] = (f32x4){0.f, 0.f, 0.f, 0.f};
        __syncthreads();
#pragma unroll
        for (int i = 0; i < 8; ++i) *(LAS u32x4*)(S + (tid + 512 * i) * 16) = (u32x4){0u, 0u, 0u, 0u};
        auto stage_kv = [&](size_t t0) {
#pragma unroll
            for (int i = 0; i < 8; ++i) { const bf16_t* kp = RK + (t0 + 16 * i + 2 * w) * 2048 + h * 256;
                __builtin_amdgcn_global_load_lds((const unsigned*)(kp + kgo), (LAS unsigned*)(Kb + (i * 8 + w) * 1024), 16, 0, 0); }
#pragma unroll
            for (int i = 0; i < 4; ++i) { const bf16_t* vp = RV + (t0 + 32 * i + 4 * w) * 4096 + h * 512 + vs * 128;
                __builtin_amdgcn_global_load_lds((const unsigned*)(vp + vgo), (LAS unsigned*)(Vs + (i * 8 + w) * 1024), 16, 0, 0); } };
        bf16x8 qf[8];
        auto load_q = [&](size_t t0) { const bf16_t* qp = RQ + (t0 + 16 * w) * 2048 + h * 256; const unsigned qo = (unsigned)(fr * 2048 + 8 * fq);
#pragma unroll
            for (int ks = 0; ks < 8; ++ks) qf[ks] = *(const bf16x8*)(qp + (qo + 32 * ks)); };
        load_q((size_t)b * 4096); stage_kv((size_t)b * 4096);
        __syncthreads();
        for (int c = 0; c < 32; ++c) {
            const size_t t0 = (size_t)b * 4096 + c * 128;
            f32x4 oacc[8];
#pragma unroll
            for (int vt = 0; vt < 8; ++vt) { f32x4 a = (f32x4){0.f, 0.f, 0.f, 0.f}; bf16x8 sfa[8];
#pragma unroll
                for (int ks = 0; ks < 8; ++ks) sfa[ks] = *(const LAS bf16x8*)(S + vt * 8192 + xb[ks & 3] + (ks >> 2) * 256);
                __builtin_amdgcn_sched_barrier(0);
#pragma unroll
                for (int ks = 0; ks < 8; ++ks) a = MFMA16(sfa[ks], qf[ks], a);
                oacc[vt] = a; }
            asm volatile("s_waitcnt vmcnt(0)" ::: "memory");
            RAW_BAR();
            unsigned pk[8][2];
#pragma unroll
            for (int mt = 0; mt < 8; ++mt) {
                f32x4 a = (f32x4){0.f, 0.f, 0.f, 0.f};
                if (mt <= w) {
                    bf16x8 kfa[8];
#pragma unroll
                    for (int ks = 0; ks < 8; ++ks) kfa[ks] = *(const LAS bf16x8*)(Kb + mt * 8192 + xb[ks & 3] + (ks >> 2) * 256);
                    __builtin_amdgcn_sched_barrier(0);
#pragma unroll
                    for (int ks = 0; ks < 8; ++ks) a = MFMA16(kfa[ks], qf[ks], a);
#pragma unroll
                    for (int j = 0; j < 4; ++j) a[j] = (mt < w || 4 * fq + j <= fr) ? a[j] : 0.f; }
                pk[mt][0] = cvt_pk_bf16(a[0], a[1]); pk[mt][1] = cvt_pk_bf16(a[2], a[3]); }
            const size_t tn = t0 + (c + 1 < 32 ? 128 : 0);
            load_q(tn);
#pragma unroll
            for (int ms = 0; ms < 4; ++ms) {
                u32x4 pw; pw.x = pk[2 * ms][0]; pw.y = pk[2 * ms][1]; pw.z = pk[2 * ms + 1][0]; pw.w = pk[2 * ms + 1][1];
                const bf16x8 pb = __builtin_bit_cast(bf16x8, pw);
                const LAS unsigned char* k0 = Kb + (32 * ms) * 512; const LAS unsigned char* v0 = Vs + (32 * ms) * 256;
                const bf16x8 kf0 = tr_frag(k0 + ktr[0], k0 + 16 * 512 + ktr[0]), kf1 = tr_frag(k0 + ktr[1], k0 + 16 * 512 + ktr[1]);
#pragma unroll
                for (int vt = 0; vt < 8; ++vt) { const bf16x8 vf = tr_frag(v0 + vtr[vt], v0 + 16 * 256 + vtr[vt]);
                    if (2 * ms <= w) oacc[vt] = MFMA16(vf, pb, oacc[vt]);
                    sacc[0][vt] = MFMA16(kf0, vf, sacc[0][vt]); sacc[1][vt] = MFMA16(kf1, vf, sacc[1][vt]); }
            }
            {
                const float dn = exp2f((float)(16 * w + fr + 1) * l2g);
                bf16_t* op = RO + (t0 + 16 * w) * 4096 + h * 512 + vs * 128 + (unsigned)(fr * 4096 + 4 * fq);
                float ss = 0.f;
#pragma unroll
                for (int vt = 0; vt < 8; ++vt) { const f32x4 o = oacc[vt] * dn; ss += o[0] * o[0] + o[1] * o[1] + o[2] * o[2] + o[3] * o[3];
                    u32x2 wv; wv.x = cvt_pk_bf16(o[0], o[1]); wv.y = cvt_pk_bf16(o[2], o[3]); *(u32x2*)(op + 16 * vt) = wv; }
                ss += shx(ss, 16); ss += shx(ss, 32);
                if (fq == 0) (SSQ + (t0 + 16 * w) * 32 + h * 4 + vs)[(unsigned)(fr * 32)] = ss;
            }
#pragma unroll
            for (int a = 0; a < 2; ++a)
#pragma unroll
                for (int v = 0; v < 8; ++v) sacc[a][v] *= gC;
            RAW_BAR();
#pragma unroll
            for (int ks = 0; ks < 8; ++ks) asm volatile("" :: "v"(qf[ks]));
            stage_kv(tn);
#pragma unroll
            for (int a = 0; a < 2; ++a)
#pragma unroll
                for (int vt = 0; vt < 8; ++vt) {
                    u32x2 wv; wv.x = cvt_pk_bf16(sacc[a][vt][0], sacc[a][vt][1]); wv.y = cvt_pk_bf16(sacc[a][vt][2], sacc[a][vt][3]);
                    *(LAS u32x2*)(S + vt * 8192 + wb[a]) = wv; }
            RAW_BAR();
        }
    }
}

constexpr int NPH = 23;
constexpr int MAXPH = NPH;
DI void decode_phase(int ph, int& type, int& a0, int& a1, int& a2) {
    a0 = 0; a1 = 0; a2 = -1;
    if (ph == 0) type = 0;
    else if (ph == 1) { type = 1; }
    else if (ph < 10) { const int q = (ph - 2) >> 1; a0 = q; if ((ph - 2) & 1) type = 3; else { type = 2; a1 = q > 0 ? 1 : 0; } }
    else if (ph == 10) { type = 4; a0 = 3; }
    else if (ph == 11) { type = 5; a0 = 0; }
    else if (ph == 12) { type = 1; a0 = 0; a1 = 1; }
    else if (ph == 13) { type = 6; a0 = 0; }
    else if (ph == 14) { type = 5; a0 = 1; }
    else if (ph == 15) { type = 1; a0 = 1; a1 = 0; a2 = 1; }
    else if (ph == 16) type = 7;
    else if (ph == 17) type = 8;
    else if (ph == 18) type = 9;
    else if (ph == 19) { type = 5; a0 = 2; }
    else if (ph == 20) { type = 1; a0 = 1; a1 = 1; a2 = 2; }
    else if (ph == 21) { type = 6; a0 = 1; }
    else { type = 5; a0 = 3; }
}
template <int TYPE> DI void run_phase(const Params& P, int a0, int a1, int a2, LAS unsigned char* L) {
    unsigned char* ws = P.ws; const float* mod = (const float*)(ws + OFF_MOD);
    pg8::StaticOrder S;
    if constexpr (TYPE == 0) { mod_gemv(P, (LAS float*)L); rotary_tables(P); __syncthreads(); convert_set(P, 0, (LAS unsigned*)L); }
    else if constexpr (TYPE == 1) { if (a2 >= 0) convert_set(P, a2, (LAS unsigned*)L); if (a0 == 0 && a1 == 0) norm_phase<false>(P, a0, a1); else norm_phase<true>(P, a0, a1); }
    else if constexpr (TYPE == 2) { if (a1) merge_phase(P, a0 - 1);
        pg8::Gemm g{(const bf16_t*)(ws + OFF_H) + (size_t)a0 * 8192 * 2048, (const bf16_t*)(ws + OFF_WQKV0), 8192, 18432, 2048};
        S.init(g.M, g.N, gridDim.x, bidx(), 4); EpiPlainBf16 E{(bf16_t*)(ws + OFF_QKVC), 8192};
        pg8::gemm_phase<EpiPlainBf16, pg8::StaticOrder>(L, g, S, E); }
    else if constexpr (TYPE == 3) attn_phase(P, L);
    else if constexpr (TYPE == 4) merge_phase(P, a0);
    else if constexpr (TYPE == 5) {
        const size_t offA = a0 == 0 ? OFF_O : (a0 == 1 ? OFF_HID0 : (a0 == 2 ? OFF_RO : OFF_HID1));
        const size_t offB = a0 == 0 ? OFF_WO0 : (a0 == 1 ? OFF_WDN0 : (a0 == 2 ? OFF_WRO : OFF_WDN1));
        const int kk = a0 == 0 ? 2048 : (a0 == 2 ? 4096 : DFF);
        const int goff = ((a0 >= 2) ? 8 * MODW : 0) + ((a0 & 1) ? 5 * DM : 2 * DM);
        pg8::Gemm g{(const bf16_t*)(ws + offA), (const bf16_t*)(ws + offB), TTOK, DM, kk};
        S.init(g.M, g.N, gridDim.x, bidx(), 4);
        if (a0 == 0) { EpiResidF2B E{P.x, (bf16_t*)(ws + OFF_XB1), mod + goff}; pg8::gemm_phase<EpiResidF2B, pg8::StaticOrder>(L, g, S, E); }
        else if (a0 == 3) { EpiResidB2F E{(const bf16_t*)(ws + OFF_XB3), P.out, mod + goff}; pg8::gemm_phase<EpiResidB2F, pg8::StaticOrder>(L, g, S, E); }
        else { EpiResidB2B E{a0 == 1 ? (const bf16_t*)(ws + OFF_XB1) : (const bf16_t*)P.out, a0 == 1 ? (bf16_t*)P.out : (bf16_t*)(ws + OFF_XB3), mod + goff};
               pg8::gemm_phase<EpiResidB2B, pg8::StaticOrder>(L, g, S, E); } }
    else if constexpr (TYPE == 6) { pg8::Gemm g{(const bf16_t*)(ws + OFF_H), (const bf16_t*)(ws + (a0 ? OFF_WUP1 : OFF_WUP0)), TTOK, 2 * DFF, 2048};
        S.init(g.M, g.N, gridDim.x, bidx()); EpiSwiGLU E{(bf16_t*)(ws + (a0 ? OFF_HID1 : OFF_HID0))};
        pg8::gemm_phase<EpiSwiGLU, pg8::StaticOrder>(L, g, S, E); }
    else if constexpr (TYPE == 7) { pg8::Gemm g{(const bf16_t*)(ws + OFF_H), (const bf16_t*)(ws + OFF_WRQKV), TTOK, 8192, 2048};
        S.init(g.M, g.N, gridDim.x, bidx());
        EpiRetQKV E{(bf16_t*)(ws + OFF_RQ), (bf16_t*)(ws + OFF_RK), (bf16_t*)(ws + OFF_RV), (const float*)(ws + OFF_COS), (const float*)(ws + OFF_SIN)};
        pg8::gemm_phase<EpiRetQKV, pg8::StaticOrder>(L, g, S, E); }
    else if constexpr (TYPE == 8) scan_phase(P, L);
    else { pg8::Gemm g{(const bf16_t*)(ws + OFF_H), (const bf16_t*)(ws + OFF_WRG), TTOK, 4096, 2048};
        S.init(g.M, g.N, gridDim.x, bidx()); EpiRetGate E{(bf16_t*)(ws + OFF_RO), (const float*)(ws + OFF_SSQ)};
        pg8::gemm_phase<EpiRetGate, pg8::StaticOrder>(L, g, S, E); }
}
#ifndef ONE_LAUNCH
#define ONE_LAUNCH 1
#endif
#if ONE_LAUNCH
DI void grid_barrier(unsigned* ctr, unsigned target) {
    asm volatile("s_waitcnt vmcnt(0)" ::: "memory");
    __syncthreads();
    if (threadIdx.x == 0) {
        __builtin_amdgcn_fence(__ATOMIC_RELEASE, "agent");
        asm volatile("s_waitcnt vmcnt(0)" ::: "memory");
        __hip_atomic_fetch_add(ctr, 1u, __ATOMIC_RELAXED, __HIP_MEMORY_SCOPE_AGENT);
        while (__hip_atomic_load(ctr, __ATOMIC_RELAXED, __HIP_MEMORY_SCOPE_AGENT) < target) __builtin_amdgcn_s_sleep(1);
        __builtin_amdgcn_fence(__ATOMIC_ACQUIRE, "agent");
        asm volatile("s_waitcnt vmcnt(0)" ::: "memory");
    }
    __syncthreads();
}
__global__ void __launch_bounds__(NTHREADS, 2) mega_fwd(Params Pin, int ph_lo, int ph_hi) {
    extern __shared__ __attribute__((aligned(16))) unsigned char shm[];
    LAS unsigned char* L = (LAS unsigned char*)shm;
    cg::grid_group grid = cg::this_grid();
    unsigned nbar = 0;
    for (int ph = ph_lo; ph < ph_hi; ++ph) {
        typedef const Params __attribute__((address_space(4))) * KP;
        KP pk = (KP)__builtin_amdgcn_kernarg_segment_ptr();
        asm volatile("" : "+s"(pk));
        Params P;
        P.x = pk->x; P.c = pk->c; P.w_mod = pk->w_mod; P.b_mod = pk->b_mod; P.norm_mix = pk->norm_mix; P.norm_ffn = pk->norm_ffn; P.rel_bias = pk->rel_bias;
        P.att_w_qkv = pk->att_w_qkv; P.att_q_gain = pk->att_q_gain; P.att_k_gain = pk->att_k_gain; P.att_w_o = pk->att_w_o; P.ret_w_qkvg = pk->ret_w_qkvg; P.ret_w_o = pk->ret_w_o;
        P.ffn_w_up = pk->ffn_w_up; P.ffn_w_down = pk->ffn_w_down; P.out = pk->out; P.ws = pk->ws;
        int type, a0, a1, a2; decode_phase(ph, type, a0, a1, a2);
        switch (type) {
            case 0: run_phase<0>(P, a0, a1, a2, L); break; case 1: run_phase<1>(P, a0, a1, a2, L); break;
            case 2: run_phase<2>(P, a0, a1, a2, L); break; case 3: run_phase<3>(P, a0, a1, a2, L); break;
            case 4: run_phase<4>(P, a0, a1, a2, L); break; case 5: run_phase<5>(P, a0, a1, a2, L); break;
            case 6: run_phase<6>(P, a0, a1, a2, L); break; case 7: run_phase<7>(P, a0, a1, a2, L); break;
            case 8: run_phase<8>(P, a0, a1, a2, L); break; default: run_phase<9>(P, a0, a1, a2, L); break;
        }
        if (ph + 1 < ph_hi) {
            unsigned* ctr = (unsigned*)(P.ws + OFF_BAR);
            if (ph == ph_lo) { if (blockIdx.x == 0 && threadIdx.x == 0) __hip_atomic_store(ctr, 0u, __ATOMIC_RELAXED, __HIP_MEMORY_SCOPE_AGENT); grid.sync(); }
            else { ++nbar; grid_barrier(ctr, nbar * gridDim.x); }
        }
    }
}
#endif
extern "C" void kernel_launch(void* const* d_in, const int* in_sizes, int n_in, void* d_out, int out_size, void* d_ws, size_t ws_size, hipStream_t stream) {
    static int grid = 0;
    if (grid == 0) {
        int dev = 0, cus = 0;
        (void)hipGetDevice(&dev);
        (void)hipDeviceGetAttribute(&cus, hipDeviceAttributeMultiprocessorCount, dev);
        grid = cus > 0 ? cus : 256;
        if (ws_size < WS_NEED) fprintf(stderr, "kernel_launch: workspace too small: %zu < %zu\n", ws_size, (size_t)WS_NEED);
    }
    Params p{};
    p.x = (const float*)d_in[0]; p.c = (const float*)d_in[1]; p.w_mod = (const float*)d_in[2]; p.b_mod = (const float*)d_in[3]; p.norm_mix = (const float*)d_in[4]; p.norm_ffn = (const float*)d_in[5];
    p.rel_bias = (const float*)d_in[6]; p.att_w_qkv = (const float*)d_in[7]; p.att_q_gain = (const float*)d_in[8]; p.att_k_gain = (const float*)d_in[9]; p.att_w_o = (const float*)d_in[10];
    p.ret_w_qkvg = (const float*)d_in[11]; p.ret_w_o = (const float*)d_in[12]; p.ffn_w_up = (const float*)d_in[13]; p.ffn_w_down = (const float*)d_in[14];
    p.out = (float*)d_out; p.ws = (unsigned char*)d_ws;
#if ONE_LAUNCH
    static bool attr = false;
    if (!attr) { (void)hipFuncSetAttribute((const void*)mega_fwd, hipFuncAttributeMaxDynamicSharedMemorySize, LDS_BYTES); attr = true; }
    int lo = 0, hi = NPH;
    void* args[] = {&p, &lo, &hi};
    hipError_t e = hipLaunchCooperativeKernel((const void*)mega_fwd, dim3(grid), dim3(NTHREADS), args, LDS_BYTES, stream);
    if (e != hipSuccess) fprintf(stderr, "kernel_launch: cooperative launch failed: %s (grid %d)\n", hipGetErrorString(e), grid);
#endif
}
```
